# Optimizing an MI355X kernel written in HIP

```python
import math
import jax, jax.numpy as jnp
from jax import lax
import numpy as np

D_MODEL = 1024
BATCH = 4
SEQ = 8192
DEPTH = 2

GRID_W = 64
CTX_LEN = 256
N_MIXERS = 2
D_FF = 4 * D_MODEL
NORM_EPS = 1e-6
LRU_WIDTH = D_MODEL
LRU_HEADS = 4
LRU_BLOCK = LRU_WIDTH // LRU_HEADS
LRU_CONV = 4
LRU_CONV_LEFT = 2
LRU_C = 8.0
N_DIRS = 2
HYENA_ORDER = 2
HYENA_CONV = 3
HYENA_CONV_LEFT = 1
FILTER_BANDS = 16
FILTER_EMB = 1 + 2 * FILTER_BANDS
FILTER_HIDDEN = 64
FILTER_TARGET = 1e-2
FAST_DECAY_PCT = 0.3
SLOW_DECAY_PCT = 1.5

kernel_name = 'hybrid_rglru_hyena_diffusion_block'


def rms_norm(x, g):
    x32 = x.astype(jnp.float32)
    y = x32 * lax.rsqrt(jnp.mean(x32 * x32, axis=-1, keepdims=True) + NORM_EPS)
    return (y * g.astype(jnp.float32)).astype(x.dtype)


def modulate(x, g, shift, scale):
    return rms_norm(x, g) * (1 + scale) + shift


def squared_relu_mlp(u, w1, w2):
    return jnp.square(jax.nn.relu(u @ w1)) @ w2


def depthwise_conv(u, w, b, left):
    K = w.shape[0]
    L = u.shape[1]
    up = jnp.pad(u, ((0, 0), (left, K - 1 - left), (0, 0)))
    return sum(up[:, k:k + L] * w[k] for k in range(K)) + b


def row_conv(u, w, b, left):
    B, L, C = u.shape
    rows = L // GRID_W
    y = depthwise_conv(u.reshape(B * rows, GRID_W, C), w, b, left)
    return y.reshape(B, L, C)


def _combine(left, right):
    a1, b1 = left
    a2, b2 = right
    return a1 * a2, a2 * b1 + b2


def linear_scan(a, bx, h0):
    a_cum, h = lax.associative_scan(_combine, (a, bx), axis=1)
    return h + a_cum * h0[:, None]


def rglru_coeffs(xc, w_a, b_a, w_i, b_i, lam):
    B, L, W = xc.shape
    x32 = xc.astype(jnp.float32)
    xh = x32.reshape(B, L, LRU_HEADS, LRU_BLOCK)
    r = jax.nn.sigmoid(jnp.einsum('blhi,ehij->eblhj', xh, w_a) + b_a[:, None, None]).reshape(N_DIRS, B, L, W)
    i = jax.nn.sigmoid(jnp.einsum('blhi,ehij->eblhj', xh, w_i) + b_i[:, None, None]).reshape(N_DIRS, B, L, W)
    log_a = -LRU_C * r * jax.nn.softplus(-lam.astype(jnp.float32))[:, None, None, :]
    a = jnp.exp(log_a)
    bx = jnp.sqrt(-jnp.expm1(2.0 * log_a)) * i * x32[None]
    return a, bx


def rglru_mixer(u, u_ctx, p, want_ctx_out):
    w_in, b_in, conv_w, conv_b, w_a, b_a, w_i, b_i, lam, w_out, b_out = p
    W = LRU_WIDTH
    B = u.shape[0]
    zeros = jnp.zeros((B, W), jnp.float32)
    xc_c = depthwise_conv(u_ctx @ w_in[:, W:] + b_in[W:], conv_w, conv_b, LRU_CONV_LEFT)
    a_c, bx_c = rglru_coeffs(xc_c, w_a, b_a, w_i, b_i, lam)
    h_cf = linear_scan(a_c[0], bx_c[0], zeros)
    h_cb = linear_scan(jnp.flip(a_c[1], 1), jnp.flip(bx_c[1], 1), zeros)
    z = u @ w_in + b_in
    gate = jax.nn.gelu(z[..., :W])
    xl = row_conv(z[..., W:], conv_w, conv_b, LRU_CONV_LEFT)
    a_l, bx_l = rglru_coeffs(xl, w_a, b_a, w_i, b_i, lam)
    h_f = linear_scan(a_l[0], bx_l[0], h_cf[:, -1])
    h_b = jnp.flip(linear_scan(jnp.flip(a_l[1], 1), jnp.flip(bx_l[1], 1), h_cb[:, -1]), 1)
    y = ((h_f + h_b).astype(gate.dtype) * gate) @ w_out + b_out
    y_ctx = None
    if want_ctx_out:
        gate_c = jax.nn.gelu(u_ctx @ w_in[:, :W] + b_in[:W])
        h_c = h_cf + jnp.flip(h_cb, 1)
        y_ctx = (h_c.astype(gate_c.dtype) * gate_c) @ w_out + b_out
    return y, y_ctx


def hyena_filters(L, fw1, fb1, fw2, fb2, fw3, fb3, fw4, freq):
    t = jnp.linspace(0.0, 1.0, L, dtype=jnp.float32)[:, None]
    w = (2.0 * math.pi / L) * jnp.arange(L, dtype=jnp.float32)[:, None]
    bands = jnp.linspace(1e-4, FILTER_BANDS - 1, FILTER_BANDS, dtype=jnp.float32)
    pos = jnp.concatenate([t, jnp.cos(bands * w), -jnp.sin(bands * w)], axis=-1)
    h = jnp.sin(freq * (pos @ fw1 + fb1))
    h = jnp.sin(freq * (h @ fw2 + fb2))
    h = jnp.sin(freq * (h @ fw3 + fb3))
    h = (h @ fw4).reshape(L, N_DIRS, HYENA_ORDER, D_MODEL)
    deltas = jnp.abs(jnp.linspace(math.log(FILTER_TARGET) / SLOW_DECAY_PCT,
                                  math.log(FILTER_TARGET) / FAST_DECAY_PCT, D_MODEL, dtype=jnp.float32))
    h = h * jnp.exp(-t * deltas)[:, None, None, :]
    h = h / jnp.sum(jnp.abs(h), axis=(0, 1), keepdims=True)
    fwd, bwd = h[:, 0], h[:, 1]
    k = jnp.concatenate([fwd[:1] + bwd[:1], fwd[1:],
                         jnp.zeros((1, HYENA_ORDER, D_MODEL), h.dtype), jnp.flip(bwd[1:], 0)], axis=0)
    return jnp.fft.rfft(k, axis=0)


def long_conv(u, k_f, bias):
    L = u.shape[1]
    u32 = u.astype(jnp.float32)
    y = jnp.fft.irfft(jnp.fft.rfft(u32, n=2 * L, axis=1) * k_f, n=2 * L, axis=1)[:, :L]
    return (y + u32 * bias).astype(u.dtype)


def hyena_operator(u, p, conv_fn):
    w_in, b_in, conv_w, conv_b, fw1, fb1, fw2, fb2, fw3, fb3, fw4, freq, skip, w_out, b_out = p
    L = u.shape[1]
    z = conv_fn(u @ w_in + b_in, conv_w, conv_b, HYENA_CONV_LEFT)
    v, x1, x2 = jnp.split(z, HYENA_ORDER + 1, axis=-1)
    k_f = hyena_filters(L, fw1, fb1, fw2, fb2, fw3, fb3, fw4, freq)
    v = x1 * long_conv(v, k_f[:, 0], skip[0])
    v = x2 * long_conv(v, k_f[:, 1], skip[1])
    return v @ w_out + b_out


def _dense(key, shape, fan_in, gain=1.0):
    return (gain * fan_in ** -0.5) * jax.random.normal(key, shape, jnp.float32)


def setup_inputs(seed: int = 0) -> dict:
    key = jax.random.key(seed)
    k = list(jax.random.split(key, 40))
    D, W, F = D_MODEL, LRU_WIDTH, FILTER_HIDDEN
    n_a = (DEPTH + 1) // 2
    n_b = DEPTH // 2
    small = lambda kk, shape: 0.02 * jax.random.normal(kk, shape, jnp.float32)
    s = jax.random.uniform(k[14], (n_a, N_DIRS, W), jnp.float32, minval=0.9, maxval=0.999) ** (1.0 / LRU_C)
    return {
        'x': jax.random.normal(k[0], (BATCH, SEQ, D), jnp.float32),
        'c': jax.random.normal(k[1], (BATCH, D), jnp.float32),
        'ctx': jax.random.normal(k[2], (BATCH, CTX_LEN, D), jnp.float32),
        'c_ctx': jax.random.normal(k[3], (D,), jnp.float32),
        'ada_w': _dense(k[4], (DEPTH, D, 6 * D), D, 0.5),
        'ada_b': small(k[5], (DEPTH, 6 * D)),
        'norm_g': 1.0 + 0.1 * jax.random.normal(k[6], (DEPTH, 2, D), jnp.float32),
        'mlp_w1': _dense(k[7], (DEPTH, D, D_FF), D),
        'mlp_w2': _dense(k[8], (DEPTH, D_FF, D), D_FF),
        'lru_w_in': _dense(k[9], (n_a, D, 2 * W), D),
        'lru_b_in': small(k[10], (n_a, 2 * W)),
        'lru_conv_w': _dense(k[11], (n_a, LRU_CONV, W), LRU_CONV),
        'lru_conv_b': small(k[12], (n_a, W)),
        'lru_w_a': _dense(k[13], (n_a, N_DIRS, LRU_HEADS, LRU_BLOCK, LRU_BLOCK), LRU_BLOCK),
        'lru_b_a': small(k[15], (n_a, N_DIRS, LRU_HEADS, LRU_BLOCK)),
        'lru_w_i': _dense(k[16], (n_a, N_DIRS, LRU_HEADS, LRU_BLOCK, LRU_BLOCK), LRU_BLOCK),
        'lru_b_i': small(k[17], (n_a, N_DIRS, LRU_HEADS, LRU_BLOCK)),
        'lru_lambda': jnp.log(s) - jnp.log1p(-s),
        'lru_w_out': _dense(k[18], (n_a, W, D), W),
        'lru_b_out': small(k[19], (n_a, D)),
        'hy_w_in': _dense(k[20], (n_b, D, (HYENA_ORDER + 1) * D), D),
        'hy_b_in': small(k[21], (n_b, (HYENA_ORDER + 1) * D)),
        'hy_conv_w': _dense(k[22], (n_b, HYENA_CONV, (HYENA_ORDER + 1) * D), HYENA_CONV),
        'hy_conv_b': small(k[23], (n_b, (HYENA_ORDER + 1) * D)),
        'hy_fw1': _dense(k[24], (n_b, FILTER_EMB, F), FILTER_EMB),
        'hy_fb1': small(k[25], (n_b, F)),
        'hy_fw2': _dense(k[26], (n_b, F, F), F),
        'hy_fb2': small(k[27], (n_b, F)),
        'hy_fw3': _dense(k[28], (n_b, F, F), F),
        'hy_fb3': small(k[29], (n_b, F)),
        'hy_fw4': _dense(k[30], (n_b, F, N_DIRS * HYENA_ORDER * D), F),
        'hy_freq': 1.0 + 0.01 * jax.random.normal(k[31], (n_b, F), jnp.float32),
        'hy_skip': jax.random.normal(k[32], (n_b, HYENA_ORDER, D), jnp.float32),
        'hy_w_out': _dense(k[33], (n_b, D, D), D),
        'hy_b_out': small(k[34], (n_b, D)),
        'final_g': 1.0 + 0.1 * jax.random.normal(k[35], (D,), jnp.float32),
    }


def reference(x, c, ctx, c_ctx, ada_w, ada_b, norm_g, mlp_w1, mlp_w2,
              lru_w_in, lru_b_in, lru_conv_w, lru_conv_b, lru_w_a, lru_b_a, lru_w_i, lru_b_i,
              lru_lambda, lru_w_out, lru_b_out,
              hy_w_in, hy_b_in, hy_conv_w, hy_conv_b, hy_fw1, hy_fb1, hy_fw2, hy_fb2,
              hy_fw3, hy_fb3, hy_fw4, hy_freq, hy_skip, hy_w_out, hy_b_out, final_g):
    cond = jax.nn.silu(c)
    cond_ctx = jax.nn.silu(c_ctx)
    h_ctx = ctx
    for i in range(DEPTH):
        j = i // N_MIXERS
        is_lru = (i % N_MIXERS) == 0
        ctx_later = any(l % N_MIXERS == 0 for l in range(i + 1, DEPTH))
        mod = (cond @ ada_w[i] + ada_b[i])[:, None, :]
        sh1, sc1, g1, sh2, sc2, g2 = jnp.split(mod, 6, axis=-1)
        u = modulate(x, norm_g[i, 0], sh1, sc1)
        u_ctx = None
        mod_c = None
        if is_lru or ctx_later:
            mod_c = jnp.split(cond_ctx @ ada_w[i] + ada_b[i], 6)
            u_ctx = modulate(h_ctx, norm_g[i, 0], mod_c[0], mod_c[1])
        if is_lru:
            p = (lru_w_in[j], lru_b_in[j], lru_conv_w[j], lru_conv_b[j], lru_w_a[j], lru_b_a[j],
                 lru_w_i[j], lru_b_i[j], lru_lambda[j], lru_w_out[j], lru_b_out[j])
            y, y_ctx = rglru_mixer(u, u_ctx, p, ctx_later)
        else:
            p = (hy_w_in[j], hy_b_in[j], hy_conv_w[j], hy_conv_b[j], hy_fw1[j], hy_fb1[j],
                 hy_fw2[j], hy_fb2[j], hy_fw3[j], hy_fb3[j], hy_fw4[j], hy_freq[j], hy_skip[j],
                 hy_w_out[j], hy_b_out[j])
            y = hyena_operator(u, p, row_conv)
            y_ctx = hyena_operator(u_ctx, p, depthwise_conv) if ctx_later else None
        x = x + g1 * y
        x = x + g2 * squared_relu_mlp(modulate(x, norm_g[i, 1], sh2, sc2), mlp_w1[i], mlp_w2[i])
        if ctx_later:
            h_ctx = h_ctx + mod_c[2] * y_ctx
            h_ctx = h_ctx + mod_c[5] * squared_relu_mlp(
                modulate(h_ctx, norm_g[i, 1], mod_c[3], mod_c[4]), mlp_w1[i], mlp_w2[i])
    return rms_norm(x, final_g)
```

```cpp
#include <hip/hip_runtime.h>
#include <hip/hip_cooperative_groups.h>
#include <cstdio>
#include <cstdint>
namespace cg = cooperative_groups;

#define HD __device__ __forceinline__
#define LAS __attribute__((address_space(3)))
typedef unsigned short bf16_t;
typedef short bf16x8 __attribute__((ext_vector_type(8)));
typedef float f32x4 __attribute__((ext_vector_type(4)));
typedef float f32x2 __attribute__((ext_vector_type(2)));
typedef unsigned u32x4 __attribute__((ext_vector_type(4)));
typedef unsigned u32x2 __attribute__((ext_vector_type(2)));

HD unsigned cvt_pk_bf16(float lo, float hi) { unsigned r; asm volatile("v_cvt_pk_bf16_f32 %0, %1, %2" : "=v"(r) : "v"(lo), "v"(hi)); return r; }
HD float bf_lo(unsigned u) { return __uint_as_float(u << 16); }
HD float bf_hi(unsigned u) { return __uint_as_float(u & 0xffff0000u); }
HD float bf2f(bf16_t b) { return __uint_as_float(((unsigned)b) << 16); }
HD bf16_t f2bf(float f) { return (bf16_t)(cvt_pk_bf16(f, 0.f) & 0xffffu); }
HD int ltid() { int t = threadIdx.x; asm volatile("" : "+v"(t)); return t; }
HD float shfl_xor_f(float v, int mask) { const int lane = ltid() & 63; return __int_as_float(__builtin_amdgcn_ds_bpermute((lane ^ mask) << 2, __float_as_int(v))); }
HD float fsigmoid(float x) { return __frcp_rn(1.0f + __expf(-x)); }

#define XB_TMO      128
#define XB_XCNT(j)  (256  + 64 * (j))
#define XB_XSUB(j)  (1280 + 64 * (j))
#define XB_XGEN(j)  (2304 + 64 * (j))
#define XB_TOP      3328
#define XB_TOPGEN   3392
#define XCD_BAR_WORDS 3456
#define XB_SPIN_CAP (1u << 18)

__device__ __forceinline__ unsigned xb_ld(unsigned* p)              { return __hip_atomic_load(p, __ATOMIC_RELAXED, __HIP_MEMORY_SCOPE_AGENT); }
__device__ __forceinline__ unsigned xb_add(unsigned* p, unsigned v) { return __hip_atomic_fetch_add(p, v, __ATOMIC_RELAXED, __HIP_MEMORY_SCOPE_AGENT); }
__device__ __forceinline__ unsigned xb_xcc_id() { return (unsigned)__builtin_amdgcn_s_getreg((3 << 11) | 20) & 0xFu; }
#define XB_SPIN(cond, bar) do { unsigned _sp = 0; while (cond) { __builtin_amdgcn_s_sleep(1); \
    if ((++_sp & 255u) == 0u) { if (xb_ld(&(bar)[XB_TMO])) break; if (_sp > XB_SPIN_CAP) { atomicAdd(&(bar)[XB_TMO], 1u); break; } } } } while (0)

struct XcdBarrier {
    unsigned* bar; unsigned x;
    volatile LAS unsigned* st;
};

__device__ __forceinline__ XcdBarrier xcd_barrier_post(unsigned* bar, volatile LAS unsigned* st) {
    XcdBarrier b; b.bar = bar; b.x = xb_xcc_id(); b.st = st;
    if (threadIdx.x == 0) (void)xb_add(&bar[XB_XCNT(b.x)], 1u);
    return b;
}
__device__ __forceinline__ void xcd_barrier_complete(unsigned* bar, unsigned x, unsigned& nloc, unsigned& nx) {
    const unsigned G = gridDim.x * gridDim.y * gridDim.z;
    unsigned sum, cnt, mine, sp = 0u;
    for (;;) {
        sum = 0u; cnt = 0u; mine = 0u;
#pragma unroll
        for (unsigned j = 0; j < 16; ++j) { const unsigned c = xb_ld(&bar[XB_XCNT(j)]); sum += c; cnt += (c > 0u) ? 1u : 0u; mine = (j == x) ? c : mine; }
        if (sum == G) break;
        __builtin_amdgcn_s_sleep(1);
        if ((++sp & 255u) == 0u) { if (xb_ld(&bar[XB_TMO])) break; if (sp > XB_SPIN_CAP) { atomicAdd(&bar[XB_TMO], 1u); break; } }
    }
    nloc = mine > 0u ? mine : 1u; nx = cnt > 0u ? cnt : 1u;
}

__device__ __forceinline__ void xcd_barrier(const XcdBarrier& b) {
    asm volatile("s_waitcnt vmcnt(0)" ::: "memory");
    __syncthreads();
    if (threadIdx.x == 0) {
        unsigned* bar = b.bar;
        __builtin_amdgcn_s_waitcnt(0);
        unsigned nloc = b.st[0], nx = b.st[1];
        if (nloc == 0u) { xcd_barrier_complete(bar, b.x, nloc, nx); b.st[0] = nloc; b.st[1] = nx; }
        const unsigned old = xb_add(&bar[XB_XSUB(b.x)], 1u);
        const unsigned gen = old / nloc;
        if (old + 1u == (gen + 1u) * nloc) {
            __builtin_amdgcn_fence(__ATOMIC_RELEASE, "agent");
            asm volatile("s_waitcnt vmcnt(0)" ::: "memory");
            const unsigned og = xb_add(&bar[XB_TOP], 1u);
            const unsigned tg = og / nx;
            if (og + 1u == (tg + 1u) * nx) xb_add(&bar[XB_TOPGEN], 1u);
            else XB_SPIN(xb_ld(&bar[XB_TOPGEN]) == tg, bar);
            __builtin_amdgcn_fence(__ATOMIC_ACQUIRE, "agent");
            xb_add(&bar[XB_XGEN(b.x)], 1u);
            asm volatile("s_waitcnt vmcnt(0)" ::: "memory");
        } else {
            XB_SPIN(xb_ld(&bar[XB_XGEN(b.x)]) == gen, bar);
            __builtin_amdgcn_fence(__ATOMIC_ACQUIRE, "agent");
            asm volatile("s_waitcnt vmcnt(0)" ::: "memory");
        }
    }
    __syncthreads();
}


namespace pg8 {
constexpr int BM = 256, BK = 64, HALF = 128, HTB = HALF * BK * 2, STAGE_BYTES = 8 * HTB, NXCD = 8, WGM = 8;
HD int lds_byte(int r, int c) { const int st = (r >> 4) * 2 + (c >> 5), rr = r & 15, cc = c & 31, ob = rr * 64 + cc * 2; return st * 1024 + (ob ^ (((ob >> 9) & 1) << 5)); }
HD void stage_rc(int b, int& R, int& C) { const int st = b / 1024, sb = b % 1024, swz = sb ^ (((sb >> 9) & 1) << 5); R = (st >> 1) * 16 + swz / 64; C = (st & 1) * 32 + (swz % 64) / 2; }
HD int perm32(int rho) { const int n = rho >> 4, i = rho & 15; return 8 * (i >> 2) + 4 * n + (i & 3); }
struct Unit { int pm, pn; };
struct Gemm { const char* A; const char* A2; const char* Bt; int lda, ldb, K, nM, nN, pm_split, apn_shift, apn_bytes; };
struct StaticOrder {
    int nM, nN, nwg, G, c;
    HD void init(int nM_, int nN_, int G_, int c_) { nM = nM_; nN = nN_; nwg = nM * nN; G = G_; c = c_; }
    HD bool next(int i, Unit& u) const {
        const long L = (long)i * G + c; if (L >= nwg) return false;
        int wgid = (int)L; { const int q = nwg / NXCD, r = nwg % NXCD, xcd = wgid % NXCD, off = wgid / NXCD; wgid = (xcd < r ? xcd * (q + 1) : r * (q + 1) + (xcd - r) * q) + off; }
        const int nig = WGM * nN, gid = wgid / nig, fm = gid * WGM, gsz = (nM - fm) < WGM ? (nM - fm) : WGM;
        u.pm = fm + ((wgid % nig) % gsz); u.pn = (wgid % nig) / gsz; return true;
    }
};

template <class Epi>
HD void gemm_phase(LAS unsigned char* lds, const Gemm g, const Epi& E) {
    const int tid = ltid(), wid = __builtin_amdgcn_readfirstlane(tid >> 6), lane = tid & 63, wr = wid >> 2, wc = wid & 3, fr = lane & 15, fq = lane >> 4;
    StaticOrder S; S.init(g.nM, g.nN, (int)gridDim.x, (int)blockIdx.x);
    const int K = g.K, nt = K / BK;
    unsigned voffA[2], voffB[2];
#pragma unroll
    for (int i = 0; i < 2; ++i) { int R, C; stage_rc(tid * 16 + i * 8192, R, C); const int Rb = Epi::PERM ? ((R & ~31) + perm32(R & 31)) : R;
        voffA[i] = (unsigned)(R * g.lda + C) * 2u; voffB[i] = (unsigned)(Rb * g.ldb + C) * 2u; }
    const size_t kstep = (size_t)(BK * 2);
    const size_t hstepA = (size_t)HALF * g.lda * 2, hstepB = (size_t)HALF * g.ldb * 2;
    const size_t tstepA = 2 * hstepA, tstepB = 2 * hstepB;
    const unsigned ldsw = (unsigned)wid * 1024u;
    const int aoff = lds_byte(wr * 64 + fr, fq * 8), boff = lds_byte(wc * 32 + fr, fq * 8);
#define PG8_APTR(u) ((((u).pm < g.pm_split) ? g.A + (size_t)(u).pm * tstepA : g.A2 + (size_t)((u).pm - g.pm_split) * tstepA) + (size_t)(((u).pn >> g.apn_shift) * g.apn_bytes))
#define PG8_BPTR(u) (g.Bt + (size_t)(u).pn * tstepB)
#define PG8_SA(b, h) (((b) * 2 + (h)) * HTB)
#define PG8_SB(b, h) ((4 + (b) * 2 + (h)) * HTB)
#define PG8_STAGE(bufoff, gbase, voff) do { _Pragma("unroll") for (int _i = 0; _i < 2; ++_i) \
        __builtin_amdgcn_global_load_lds((const unsigned*)((const char*)(gbase) + (voff)[_i]), (LAS unsigned*)(lds + (bufoff) + ldsw + _i * 8192), 16, 0, 0); } while (0)
#define PG8_LDA(dst, b, h) do { _Pragma("unroll") for (int m = 0; m < 4; ++m) _Pragma("unroll") for (int k = 0; k < 2; ++k) dst[m][k] = *(const LAS bf16x8*)(lds + PG8_SA(b, h) + aoff + m * 2048 + k * 1024); } while (0)
#define PG8_LDB(dst, b, h) do { _Pragma("unroll") for (int n = 0; n < 2; ++n) _Pragma("unroll") for (int k = 0; k < 2; ++k) dst[n][k] = *(const LAS bf16x8*)(lds + PG8_SB(b, h) + boff + n * 2048 + k * 1024); } while (0)
#define PG8_MMA(ai, bj, At, Bt) do { __builtin_amdgcn_s_setprio(1); _Pragma("unroll") for (int m = 0; m < 4; ++m) _Pragma("unroll") for (int n = 0; n < 2; ++n) _Pragma("unroll") for (int k = 0; k < 2; ++k) \
        acc[ai][bj][m][n] = __builtin_amdgcn_mfma_f32_16x16x32_bf16(Bt[n][k], At[m][k], acc[ai][bj][m][n], 0, 0, 0); __builtin_amdgcn_s_setprio(0); } while (0)
#define PG8_WAIT_V(n) asm volatile("s_waitcnt vmcnt(" #n ")" ::: "memory")
#define PG8_WAIT_L(n) asm volatile("s_waitcnt lgkmcnt(" #n ")" ::: "memory")
#define PG8_BAR __builtin_amdgcn_s_barrier()
#define PG8_SCHED __builtin_amdgcn_sched_barrier(0)
    Unit cur, nxt; int ui = 0;
    if (!S.next(0, cur)) return;
    f32x4 acc[2][2][4][2];
#pragma unroll
    for (int a = 0; a < 2; ++a)
#pragma unroll
        for (int b = 0; b < 2; ++b)
#pragma unroll
            for (int m = 0; m < 4; ++m)
#pragma unroll
                for (int n = 0; n < 2; ++n) acc[a][b][m][n] = (f32x4){0.f, 0.f, 0.f, 0.f};
    bf16x8 At[4][2], B0[2][2], B1[2][2];
    const char* cA = PG8_APTR(cur); const char* cB = PG8_BPTR(cur);
    PG8_STAGE(PG8_SB(0, 0), cB, voffB); PG8_STAGE(PG8_SA(0, 0), cA, voffA); PG8_STAGE(PG8_SB(0, 1), cB + hstepB, voffB); PG8_STAGE(PG8_SA(0, 1), cA + hstepA, voffA);
    if (wr == 1) PG8_BAR;
    PG8_WAIT_V(4); PG8_BAR;
    PG8_STAGE(PG8_SB(1, 0), cB + kstep, voffB); PG8_STAGE(PG8_SA(1, 0), cA + kstep, voffA); PG8_STAGE(PG8_SB(1, 1), cB + hstepB + kstep, voffB);
    PG8_WAIT_V(6); PG8_BAR;
    for (;;) {
        const bool has_next = S.next(ui + 1, nxt);
        const char* nA = has_next ? PG8_APTR(nxt) : cA; const char* nB = has_next ? PG8_BPTR(nxt) : cB;
#pragma unroll 1
        for (int t = 0; t < nt; t += 2) {
            const bool last = (t == nt - 2);
            const char* a1 = cA + (size_t)(t + 1) * kstep;
            const char* a2 = last ? nA : cA + (size_t)(t + 2) * kstep; const char* b2 = last ? nB : cB + (size_t)(t + 2) * kstep;
            const char* a3 = a2 + kstep; const char* b3 = b2 + kstep;
            PG8_LDB(B0, 0, 0); PG8_SCHED; PG8_LDA(At, 0, 0); PG8_STAGE(PG8_SA(1, 1), a1 + hstepA, voffA);
            PG8_WAIT_L(8); PG8_BAR; PG8_WAIT_L(0); PG8_MMA(0, 0, At, B0); PG8_BAR; PG8_SCHED;
            PG8_LDB(B1, 0, 1); PG8_STAGE(PG8_SB(0, 0), b2, voffB);
            PG8_BAR; PG8_WAIT_L(0); PG8_MMA(0, 1, At, B1); PG8_BAR;
            PG8_LDA(At, 0, 1); PG8_STAGE(PG8_SA(0, 0), a2, voffA);
            PG8_BAR; PG8_WAIT_L(0); PG8_MMA(1, 0, At, B0); PG8_BAR; PG8_SCHED;
            PG8_STAGE(PG8_SB(0, 1), b2 + hstepB, voffB);
            PG8_WAIT_V(6); PG8_BAR; PG8_MMA(1, 1, At, B1); PG8_BAR;
            PG8_LDB(B0, 1, 0); PG8_SCHED; PG8_LDA(At, 1, 0); PG8_STAGE(PG8_SA(0, 1), a2 + hstepA, voffA);
            PG8_WAIT_L(8); PG8_BAR; PG8_WAIT_L(0); PG8_MMA(0, 0, At, B0); PG8_BAR; PG8_SCHED;
            PG8_LDB(B1, 1, 1); PG8_STAGE(PG8_SB(1, 0), b3, voffB);
            PG8_BAR; PG8_WAIT_L(0); PG8_MMA(0, 1, At, B1); PG8_BAR;
            PG8_LDA(At, 1, 1); PG8_STAGE(PG8_SA(1, 0), a3, voffA);
            PG8_BAR; PG8_WAIT_L(0); PG8_MMA(1, 0, At, B0); PG8_BAR; PG8_SCHED;
            PG8_STAGE(PG8_SB(1, 1), b3 + hstepB, voffB);
            PG8_WAIT_V(6); PG8_BAR; PG8_MMA(1, 1, At, B1); PG8_BAR;
        }
        E(acc, cur, wr, wc, fr, fq);
        if (!has_next) break;
#pragma unroll
        for (int a = 0; a < 2; ++a)
#pragma unroll
            for (int b = 0; b < 2; ++b)
#pragma unroll
                for (int m = 0; m < 4; ++m)
#pragma unroll
                    for (int n = 0; n < 2; ++n) acc[a][b][m][n] = (f32x4){0.f, 0.f, 0.f, 0.f};
        cur = nxt; cA = nA; cB = nB; ++ui;
    }
    PG8_WAIT_V(0);
    if (wr == 0) PG8_BAR;
    PG8_BAR;
#undef PG8_APTR
#undef PG8_BPTR
#undef PG8_SA
#undef PG8_SB
#undef PG8_STAGE
#undef PG8_LDA
#undef PG8_LDB
#undef PG8_MMA
#undef PG8_WAIT_V
#undef PG8_WAIT_L
#undef PG8_BAR
#undef PG8_SCHED
}
}
using pg8::Unit;
#ifndef HD
#define HD __device__ __forceinline__
#endif
#if defined(__HIP_DEVICE_COMPILE__)
#define OPAQUE(x) asm volatile("" : "+v"(x))
#else
#define OPAQUE(x)
#endif
#if defined(__HIP_DEVICE_COMPILE__)
#define LDSQ __attribute__((address_space(3)))
#else
#define LDSQ
#endif
#if defined(__HIP_DEVICE_COMPILE__)
#define FFT_SCHED_FENCE() __builtin_amdgcn_sched_barrier(0)
#else
#define FFT_SCHED_FENCE()
#endif
typedef float v2 __attribute__((ext_vector_type(2)));
struct c2 { v2 re, im; };
HD c2 c2add(c2 a, c2 b) { return c2{a.re + b.re, a.im + b.im}; }
HD c2 c2sub(c2 a, c2 b) { return c2{a.re - b.re, a.im - b.im}; }
HD c2 c2mul(c2 a, c2 b) { return c2{a.re * b.re - a.im * b.im, a.re * b.im + a.im * b.re}; }
HD c2 c2mulc(c2 a, c2 b) { return c2{a.re * b.re + a.im * b.im, a.im * b.re - a.re * b.im}; }
HD int PIX(int i) { return i + ((i >> 6) << 2); }
#define FFT_PLANE 17408
#define BREV4(j) ((((j) & 1) << 3) | (((j) & 2) << 1) | (((j) & 4) >> 1) | (((j) & 8) >> 3))

template <int K, bool CONJ> HD c2 mulw16(c2 a) {
    constexpr float C[8] = {1.f, 0.92387953251128674f, 0.70710678118654752f, 0.38268343236508977f, 0.f, -0.38268343236508977f, -0.70710678118654752f, -0.92387953251128674f};
    constexpr float S[8] = {0.f, -0.38268343236508977f, -0.70710678118654752f, -0.92387953251128674f, -1.f, -0.92387953251128674f, -0.70710678118654752f, -0.38268343236508977f};
    if (K == 0) return a;
    if (K == 4) return CONJ ? c2{-a.im, a.re} : c2{a.im, -a.re};
    const float c = C[K], s = CONJ ? -S[K] : S[K];
    return c2{a.re * c - a.im * s, a.re * s + a.im * c};
}
HD void dft16_fwd(c2 (&e)[16]) {
#define BF_F(i0, i1, K) { const c2 a = e[i0], b = e[i1]; e[i0] = c2add(a, b); e[i1] = mulw16<K, false>(c2sub(a, b)); }
    BF_F(0, 8, 0) BF_F(1, 9, 1) BF_F(2, 10, 2) BF_F(3, 11, 3) BF_F(4, 12, 4) BF_F(5, 13, 5) BF_F(6, 14, 6) BF_F(7, 15, 7)
    BF_F(0, 4, 0) BF_F(1, 5, 2) BF_F(2, 6, 4) BF_F(3, 7, 6) BF_F(8, 12, 0) BF_F(9, 13, 2) BF_F(10, 14, 4) BF_F(11, 15, 6)
    BF_F(0, 2, 0) BF_F(1, 3, 4) BF_F(4, 6, 0) BF_F(5, 7, 4) BF_F(8, 10, 0) BF_F(9, 11, 4) BF_F(12, 14, 0) BF_F(13, 15, 4)
    BF_F(0, 1, 0) BF_F(2, 3, 0) BF_F(4, 5, 0) BF_F(6, 7, 0) BF_F(8, 9, 0) BF_F(10, 11, 0) BF_F(12, 13, 0) BF_F(14, 15, 0)
#undef BF_F
}
HD void dft16_inv(c2 (&e)[16]) {
#define BF_I(i0, i1, K) { const c2 a = e[i0], b = mulw16<K, true>(e[i1]); e[i0] = c2add(a, b); e[i1] = c2sub(a, b); }
    BF_I(0, 1, 0) BF_I(2, 3, 0) BF_I(4, 5, 0) BF_I(6, 7, 0) BF_I(8, 9, 0) BF_I(10, 11, 0) BF_I(12, 13, 0) BF_I(14, 15, 0)
    BF_I(0, 2, 0) BF_I(1, 3, 4) BF_I(4, 6, 0) BF_I(5, 7, 4) BF_I(8, 10, 0) BF_I(9, 11, 4) BF_I(12, 14, 0) BF_I(13, 15, 4)
    BF_I(0, 4, 0) BF_I(1, 5, 2) BF_I(2, 6, 4) BF_I(3, 7, 6) BF_I(8, 12, 0) BF_I(9, 13, 2) BF_I(10, 14, 4) BF_I(11, 15, 6)
    BF_I(0, 8, 0) BF_I(1, 9, 1) BF_I(2, 10, 2) BF_I(3, 11, 3) BF_I(4, 12, 4) BF_I(5, 13, 5) BF_I(6, 14, 6) BF_I(7, 15, 7)
#undef BF_I
}
HD void fft_sincos_rev(float rev, float& s, float& c) {
#if defined(__HIP_DEVICE_COMPILE__)
    s = __builtin_amdgcn_sinf(rev); c = __builtin_amdgcn_cosf(rev);
#else
    s = sinf(6.283185307179586f * rev); c = cosf(6.283185307179586f * rev);
#endif
}
template <int Q, bool INV, bool HALF>
HD void fft_pass16(float* re, float* im, int tid) {
    OPAQUE(tid);
    constexpr int QP = (Q >= 64) ? Q + (Q >> 6) * 4 : Q;
    const int low = 2 * (tid & (Q / 2 - 1)), grp = tid / (Q / 2), pb = PIX(grp * 16 * Q + low), pg = grp * 68;
    float* const rb = re + pb; float* const ib = im + pb;
    c2 tw[16];
    { float sa, ca, sb, cb; fft_sincos_rev((float)low * (1.0f / (16.0f * Q)), sa, ca); fft_sincos_rev((float)(low + 1) * (1.0f / (16.0f * Q)), sb, cb);
      tw[1] = c2{v2{ca, cb}, v2{-sa, -sb}}; }
    tw[2] = c2mul(tw[1], tw[1]); tw[3] = c2mul(tw[2], tw[1]); tw[4] = c2mul(tw[2], tw[2]);
    tw[5] = c2mul(tw[4], tw[1]); tw[6] = c2mul(tw[4], tw[2]); tw[7] = c2mul(tw[4], tw[3]); tw[8] = c2mul(tw[4], tw[4]);
#pragma unroll
    for (int k = 9; k < 16; ++k) tw[k] = c2mul(tw[8], tw[k - 8]);
    c2 e[16];
    if (!INV) {
#pragma unroll
        for (int m = 0; m < 16; ++m) {
            if (HALF && m >= 8) e[m] = c2{v2{0.f, 0.f}, v2{0.f, 0.f}};
            else { e[m].re = *(const v2*)(rb + m * QP); e[m].im = *(const v2*)(ib + m * QP); }
        }
        dft16_fwd(e);
        if (Q == 4) {
#pragma unroll
            for (int q = 0; q < 8; ++q) {
                const int k0 = 2 * q, k1 = 2 * q + 1;
                const c2 o0 = (k0 == 0) ? e[BREV4(k0)] : c2mul(e[BREV4(k0)], tw[k0]), o1 = c2mul(e[BREV4(k1)], tw[k1]);
                const int pos = pg + q * 8 + low;
                *(v2*)(re + pos) = v2{o0.re.x, o1.re.x}; *(v2*)(re + pos + 4) = v2{o0.re.y, o1.re.y};
                *(v2*)(im + pos) = v2{o0.im.x, o1.im.x}; *(v2*)(im + pos + 4) = v2{o0.im.y, o1.im.y};

            }
        } else {
#pragma unroll
            for (int j = 0; j < 16; ++j) { const int k = BREV4(j); const c2 o = (k == 0) ? e[j] : c2mul(e[j], tw[k]); *(v2*)(rb + k * QP) = o.re; *(v2*)(ib + k * QP) = o.im; }
        }
    } else {
        if (Q == 4) {
#pragma unroll
            for (int q = 0; q < 8; ++q) {
                const int k0 = 2 * q, k1 = 2 * q + 1, pos = pg + q * 8 + low;
                const v2 ra = *(const v2*)(re + pos), rb2 = *(const v2*)(re + pos + 4), ia = *(const v2*)(im + pos), ib2 = *(const v2*)(im + pos + 4);
                const c2 v0{v2{ra.x, rb2.x}, v2{ia.x, ib2.x}}, v1{v2{ra.y, rb2.y}, v2{ia.y, ib2.y}};
                e[BREV4(k0)] = (k0 == 0) ? v0 : c2mulc(v0, tw[k0]); e[BREV4(k1)] = c2mulc(v1, tw[k1]);
                if (q == 3) FFT_SCHED_FENCE();

            }
        } else {
#pragma unroll
            for (int j = 0; j < 16; ++j) { const int k = BREV4(j); c2 v; v.re = *(const v2*)(rb + k * QP); v.im = *(const v2*)(ib + k * QP); e[j] = (k == 0) ? v : c2mulc(v, tw[k]); }
        }
        dft16_inv(e);
#pragma unroll
        for (int m = 0; m < 16; ++m) if (!(HALF && m >= 8)) { *(v2*)(rb + m * QP) = e[m].re; *(v2*)(ib + m * QP) = e[m].im; }
    }
}
HD void dft4_fwd(c2& a, c2& b, c2& c, c2& d) {
    const c2 s0 = c2add(a, c), s1 = c2sub(a, c), s2 = c2add(b, d), s3 = c2sub(b, d);
    a = c2add(s0, s2); c = c2sub(s0, s2);
    b = c2{s1.re + s3.im, s1.im - s3.re};
    d = c2{s1.re - s3.im, s1.im + s3.re};
}
HD void dft4_inv(c2& a, c2& b, c2& c, c2& d) {
    const c2 s0 = c2add(a, c), s1 = c2sub(a, c), s2 = c2add(b, d), s3 = c2sub(b, d);
    a = c2add(s0, s2); c = c2sub(s0, s2);
    b = c2{s1.re - s3.im, s1.im + s3.re};
    d = c2{s1.re + s3.im, s1.im - s3.re};
}
typedef float v4 __attribute__((ext_vector_type(4)));
template <int MODE>
HD void fft_r4(float* re, float* im, float* spre, float* spim, float scale, int tid) {
    OPAQUE(tid);
#pragma unroll
    for (int it = 0; it < 4; ++it) {
        const int j = tid + 512 * it;
        const int off = (j >> 3) * 68 + (j & 7) * 8;
        const v4 r0 = *(const v4*)(re + off), r1 = *(const v4*)(re + off + 4), i0 = *(const v4*)(im + off), i1 = *(const v4*)(im + off + 4);
        c2 a{v2{r0.x, r0.y}, v2{i0.x, i0.y}}, c{v2{r0.z, r0.w}, v2{i0.z, i0.w}}, b{v2{r1.x, r1.y}, v2{i1.x, i1.y}}, d{v2{r1.z, r1.w}, v2{i1.z, i1.w}};
        dft4_fwd(a, b, c, d);
        if (MODE == 0) {
            *(v4*)(spre + j * 8) = v4{a.re.x, a.re.y, c.re.x, c.re.y} * scale; *(v4*)(spre + j * 8 + 4) = v4{b.re.x, b.re.y, d.re.x, d.re.y} * scale;
            *(v4*)(spim + j * 8) = v4{a.im.x, a.im.y, c.im.x, c.im.y} * scale; *(v4*)(spim + j * 8 + 4) = v4{b.im.x, b.im.y, d.im.x, d.im.y} * scale;
        } else {
            const v4 kr0 = *(const v4*)(spre + j * 8), kr1 = *(const v4*)(spre + j * 8 + 4), ki0 = *(const v4*)(spim + j * 8), ki1 = *(const v4*)(spim + j * 8 + 4);
            a = c2mul(a, c2{v2{kr0.x, kr0.y}, v2{ki0.x, ki0.y}}); c = c2mul(c, c2{v2{kr0.z, kr0.w}, v2{ki0.z, ki0.w}});
            b = c2mul(b, c2{v2{kr1.x, kr1.y}, v2{ki1.x, ki1.y}}); d = c2mul(d, c2{v2{kr1.z, kr1.w}, v2{ki1.z, ki1.w}});
            dft4_inv(a, b, c, d);
            *(v4*)(re + off) = v4{a.re.x, a.re.y, c.re.x, c.re.y}; *(v4*)(re + off + 4) = v4{b.re.x, b.re.y, d.re.x, d.re.y};
            *(v4*)(im + off) = v4{a.im.x, a.im.y, c.im.x, c.im.y}; *(v4*)(im + off + 4) = v4{b.im.x, b.im.y, d.im.x, d.im.y};
        }
    }
}
HD int fft_slot_of_freq(int f) { const int k1 = f & 15, k2 = (f >> 4) & 15, k3 = (f >> 8) & 15, k4 = f >> 12; return (16 * k1 + k2) * 64 + (k3 >> 1) * 8 + 4 * (k4 & 1) + 2 * (k4 >> 1) + (k3 & 1); }
HD int fft_freq_of_slot(int s) { const int b = s >> 6, k1 = b >> 4, k2 = b & 15, w = s & 7, k3 = 2 * ((s >> 3) & 7) + (w & 1), k4 = ((w >> 2) & 1) + 2 * ((w >> 1) & 1); return k1 + 16 * k2 + 256 * k3 + 4096 * k4; }
HD void fft_hermitian_unpack(const float* re, const float* im, float* sp0, float* sp1, float scale, int tid) {
    OPAQUE(tid);
    const float h = 0.5f * scale;
#pragma unroll 4
    for (int it = 0; it < 32; ++it) {
        const int s = tid + 512 * it, f = fft_freq_of_slot(s), s2 = fft_slot_of_freq((16384 - f) & 16383);
        const int p = (s >> 6) * 68 + (s & 63), p2 = (s2 >> 6) * 68 + (s2 & 63);
        const float zr = re[p], zi = im[p], wr = re[p2], wi = im[p2];
        sp0[s] = (zr + wr) * h; sp0[16384 + s] = (zi - wi) * h;
        sp1[s] = (zi + wi) * h; sp1[16384 + s] = (wr - zr) * h;
    }
}
HD void fft_r4_fwd_inplace(float* re, float* im, int tid) {
    OPAQUE(tid);
#pragma unroll
    for (int it = 0; it < 4; ++it) {
        const int j = tid + 512 * it;
        const int off = (j >> 3) * 68 + (j & 7) * 8;
        const v4 r0 = *(const v4*)(re + off), r1 = *(const v4*)(re + off + 4), i0 = *(const v4*)(im + off), i1 = *(const v4*)(im + off + 4);
        c2 a{v2{r0.x, r0.y}, v2{i0.x, i0.y}}, c{v2{r0.z, r0.w}, v2{i0.z, i0.w}}, b{v2{r1.x, r1.y}, v2{i1.x, i1.y}}, d{v2{r1.z, r1.w}, v2{i1.z, i1.w}};
        dft4_fwd(a, b, c, d);
        *(v4*)(re + off) = v4{a.re.x, a.re.y, c.re.x, c.re.y}; *(v4*)(re + off + 4) = v4{b.re.x, b.re.y, d.re.x, d.re.y};
        *(v4*)(im + off) = v4{a.im.x, a.im.y, c.im.x, c.im.y}; *(v4*)(im + off + 4) = v4{b.im.x, b.im.y, d.im.x, d.im.y};
    }
}
constexpr int D = 1024, NB = 4, SEQ = 8192, M = NB * SEQ, CTXL = 256, MC = NB * CTXL, NT = 512;
constexpr size_t MiB = 1ull << 20;
constexpr size_t OFF_MOD = 0;
constexpr size_t OFF_BAR = 240 * 1024;
constexpr size_t OFF_SS = 256 * 1024;
constexpr size_t OFF_SHW = 14 * MiB + 512 * 1024;
constexpr size_t MOD_BYTES = 832 * 1024;
constexpr size_t OFF_SP = 15 * MiB;
constexpr size_t OFF_BH3 = 1 * MiB;
constexpr size_t OFF_FW4T = 5 * MiB;
constexpr size_t OFF_SSI = 256 * 1024;
constexpr size_t OFF_MODP = 7 * MiB;
constexpr size_t OFF_SHWP = 472 * MiB;
constexpr size_t OFF_W = 16 * MiB;
constexpr size_t W_IN0 = OFF_W, W_GATE = W_IN0 + 4 * MiB, W_OUT0 = W_GATE + 2 * MiB, W_M1_0 = W_OUT0 + 2 * MiB, W_M2_0 = W_M1_0 + 8 * MiB,
                 W_HYIN = W_M2_0 + 8 * MiB, W_HYOUT = W_HYIN + 6 * MiB, W_M1_1 = W_HYOUT + 2 * MiB, W_M2_1 = W_M1_1 + 8 * MiB;
constexpr size_t OFF_U = 64 * MiB;
constexpr size_t OFF_HG = 128 * MiB;
constexpr size_t OFF_LA = 192 * MiB;
constexpr size_t OFF_BX = 320 * MiB;
constexpr size_t OFF_UC = 448 * MiB;
constexpr size_t OFF_ZRC = 450 * MiB;
constexpr size_t OFF_LAC = 452 * MiB;
constexpr size_t OFF_BXC = 456 * MiB;
constexpr size_t OFF_SUMA = 460 * MiB;
constexpr size_t OFF_SUMH = 466 * MiB;
constexpr size_t OFF_H = 128 * MiB;
constexpr size_t OFF_XF = 384 * MiB;
constexpr size_t OFF_Z3 = 128 * MiB;
constexpr size_t OFF_T = 320 * MiB;
constexpr size_t OFF_HRAW = 64 * MiB;
constexpr size_t OFF_SPEC = 128 * MiB;
constexpr size_t OFF_Y2 = 192 * MiB;
constexpr size_t WS_NEED = 512 * MiB;
constexpr int LDS_BYTES = 140 * 1024;

struct Params { const float* in[36]; float* out; unsigned char* ws; int ph_lo, ph_hi; };
enum { I_X = 0, I_C, I_CTX, I_CCTX, I_ADAW, I_ADAB, I_NORMG, I_W1, I_W2, I_LWIN, I_LBIN, I_LCW, I_LCB, I_LWA, I_LBA, I_LWI, I_LBI, I_LAM, I_LWO, I_LBO,
       I_HWIN, I_HBIN, I_HCW, I_HCB, I_FW1, I_FB1, I_FW2, I_FB2, I_FW3, I_FB3, I_FW4, I_FREQ, I_SKIP, I_HWO, I_HBO, I_FG };

struct EpiIn0 {
    static constexpr bool PERM = true;
    bf16_t* G; bf16_t* ZR; bf16_t* ZRc; const float* bias;
    HD void operator()(const f32x4 (&acc)[2][2][4][2], const Unit& u, int wr, int wc, int fr, int fq) const {
        const bool isctx = u.pm >= 128, isgate = u.pn < 4;
        if (isctx && isgate) return;
        const int row0 = (isctx ? (u.pm - 128) : u.pm) * 256 + wr * 64 + fr;
        const int colg = u.pn * 256 + wc * 32 + 8 * fq;
        const int colo = isgate ? colg : colg - 1024;
        if (isctx) body<false>(acc, ZRc, row0, colg, colo); else if (isgate) body<true>(acc, G, row0, colg, colo); else body<false>(acc, ZR, row0, colg, colo);
    }
    template <bool isgate> HD void body(const f32x4 (&acc)[2][2][4][2], bf16_t* base, int row0, int colg, int colo) const {
#pragma unroll
        for (int bj = 0; bj < 2; ++bj) {
            const f32x4 b0 = *(const f32x4*)(bias + colg + bj * 128), b1 = *(const f32x4*)(bias + colg + bj * 128 + 4);
#pragma unroll
            for (int ai = 0; ai < 2; ++ai)
#pragma unroll
                for (int m = 0; m < 4; ++m) {
                    f32x4 v0 = acc[ai][bj][m][0] + b0, v1 = acc[ai][bj][m][1] + b1;
                    if (isgate) {
#pragma unroll
                        for (int j = 0; j < 4; ++j) {
                            float x = v0[j]; v0[j] = x * fsigmoid(1.5957691216f * (x + 0.044715f * x * x * x));
                            x = v1[j]; v1[j] = x * fsigmoid(1.5957691216f * (x + 0.044715f * x * x * x));
                        }
                    }
                    u32x4 w; w.x = cvt_pk_bf16(v0[0], v0[1]); w.y = cvt_pk_bf16(v0[2], v0[3]); w.z = cvt_pk_bf16(v1[0], v1[1]); w.w = cvt_pk_bf16(v1[2], v1[3]);
                    *(u32x4*)(base + (size_t)(row0 + ai * 128 + m * 16) * 1024 + colo + bj * 128) = w;
                }
        }
    }
};
struct EpiBf16 {
    static constexpr bool PERM = true;
    bf16_t* O; int ldc; const float* bias; int act; const unsigned long long* ss; const float* shw;
    HD void operator()(const f32x4 (&acc)[2][2][4][2], const Unit& u, int wr, int wc, int fr, int fq) const {
        const int row0 = u.pm * 256 + wr * 64 + fr, col0 = u.pn * 256 + wc * 32 + 8 * fq;
        float rs[2][4]; f32x4 bb[2][2];
#pragma unroll
        for (int ai = 0; ai < 2; ++ai)
#pragma unroll
            for (int m = 0; m < 4; ++m) rs[ai][m] = ss ? (float)ss[row0 + ai * 128 + m * 16] * (1.0f / 65536.0f) : 0.f;
#pragma unroll
        for (int bj = 0; bj < 2; ++bj) {
            bb[bj][0] = (f32x4){0.f, 0.f, 0.f, 0.f}; bb[bj][1] = bb[bj][0];
            if (bias) { bb[bj][0] = *(const f32x4*)(bias + col0 + bj * 128); bb[bj][1] = *(const f32x4*)(bias + col0 + bj * 128 + 4); }
            if (ss) { const float* sw = shw + (size_t)((u.pm * 256) >> 13) * ldc + col0 + bj * 128; bb[bj][0] += *(const f32x4*)sw; bb[bj][1] += *(const f32x4*)(sw + 4); }
        }
#pragma unroll
        for (int ai = 0; ai < 2; ++ai)
#pragma unroll
            for (int m = 0; m < 4; ++m) rs[ai][m] = ss ? rsqrtf(rs[ai][m] * (1.0f / 1024.0f) + 1e-6f) : 1.0f;
#pragma unroll
        for (int bj = 0; bj < 2; ++bj) {
#pragma unroll
            for (int ai = 0; ai < 2; ++ai)
#pragma unroll
                for (int m = 0; m < 4; ++m) {
                    f32x4 v0 = acc[ai][bj][m][0] * rs[ai][m] + bb[bj][0], v1 = acc[ai][bj][m][1] * rs[ai][m] + bb[bj][1];
                    if (act == 1) {
#pragma unroll
                        for (int j = 0; j < 4; ++j) { float x = fmaxf(v0[j], 0.f); v0[j] = x * x; x = fmaxf(v1[j], 0.f); v1[j] = x * x; }
                    }
                    u32x4 w; w.x = cvt_pk_bf16(v0[0], v0[1]); w.y = cvt_pk_bf16(v0[2], v0[3]); w.z = cvt_pk_bf16(v1[0], v1[1]); w.w = cvt_pk_bf16(v1[2], v1[3]);
                    *(u32x4*)(O + (size_t)(row0 + ai * 128 + m * 16) * ldc + col0 + bj * 128) = w;
                }
        }
    }
};
template <int DEPTH, bool XIN_BF, bool XOUT_BF> struct EpiRes {
    static constexpr bool PERM = true;
    const void* xin; void* xout; const float* gate;   const float* bias;
    bf16_t* U; const float* gn; const float* scn; unsigned long long* ss;
    HD void operator()(f32x4 (&acc)[2][2][4][2], const Unit& u, int wr, int wc, int fr, int fq) const {
        const int row0 = u.pm * 256 + wr * 64 + fr, col0 = u.pn * 256 + wc * 32 + 8 * fq;
        const int b = (u.pm * 256) >> 13;
        float sq[2][4];
#pragma unroll
        for (int ai = 0; ai < 2; ++ai)
#pragma unroll
            for (int m = 0; m < 4; ++m) sq[ai][m] = 0.f;
#pragma unroll
        for (int bj = 0; bj < 2; ++bj) {
            const int c = col0 + bj * 128;
            constexpr int NB_ = DEPTH + 1;
            f32x4 xb[XIN_BF ? 1 : NB_][2]; u32x4 xh[XIN_BF ? NB_ : 1];
#define ER_LOAD(s) { const size_t ro_ = (size_t)(row0 + ((s) >> 2) * 128 + ((s) & 3) * 16) * 1024 + c; \
                if (XIN_BF) xh[XIN_BF ? (s) % NB_ : 0] = *(const u32x4*)((const bf16_t*)xin + ro_); \
                else { xb[XIN_BF ? 0 : (s) % NB_][0] = *(const f32x4*)((const float*)xin + ro_); xb[XIN_BF ? 0 : (s) % NB_][1] = *(const f32x4*)((const float*)xin + ro_ + 4); } }
#pragma unroll
            for (int s0 = 0; s0 < DEPTH; ++s0) ER_LOAD(s0)
            f32x4 gs0 = (f32x4){0.f, 0.f, 0.f, 0.f}, gs1 = gs0;
            if (bias) { const f32x4 bv0 = *(const f32x4*)(bias + c), bv1 = *(const f32x4*)(bias + c + 4);
#pragma unroll
                for (int ai = 0; ai < 2; ++ai)
#pragma unroll
                    for (int m = 0; m < 4; ++m) { acc[ai][bj][m][0] += bv0; acc[ai][bj][m][1] += bv1; } }
            const f32x4 gv0 = *(const f32x4*)(gate + b * 6144 + c), gv1 = *(const f32x4*)(gate + b * 6144 + c + 4);
            if (U) { gs0 = *(const f32x4*)(gn + c) * (*(const f32x4*)(scn + b * 6144 + c) + 1.0f); gs1 = *(const f32x4*)(gn + c + 4) * (*(const f32x4*)(scn + b * 6144 + c + 4) + 1.0f); }
#pragma unroll
            for (int s = 0; s < 8; ++s) {
                if (s + DEPTH < 8) ER_LOAD(s + DEPTH)
                {
                    const int ai = s >> 2, m = s & 3;
                    const size_t ro = (size_t)(row0 + ai * 128 + m * 16) * 1024 + c;
                    f32x4 xi0, xi1;
                    if (XIN_BF) { const u32x4 h = xh[XIN_BF ? s % NB_ : 0]; xi0 = (f32x4){bf_lo(h.x), bf_hi(h.x), bf_lo(h.y), bf_hi(h.y)}; xi1 = (f32x4){bf_lo(h.z), bf_hi(h.z), bf_lo(h.w), bf_hi(h.w)}; }
                    else { xi0 = xb[XIN_BF ? 0 : s % NB_][0]; xi1 = xb[XIN_BF ? 0 : s % NB_][1]; }
                    const f32x4 x0 = xi0 + gv0 * acc[ai][bj][m][0], x1 = xi1 + gv1 * acc[ai][bj][m][1];
                    if (XOUT_BF) { u32x4 wx; wx.x = cvt_pk_bf16(x0[0], x0[1]); wx.y = cvt_pk_bf16(x0[2], x0[3]); wx.z = cvt_pk_bf16(x1[0], x1[1]); wx.w = cvt_pk_bf16(x1[2], x1[3]); *(u32x4*)((bf16_t*)xout + ro) = wx; }
                    else { *(f32x4*)((float*)xout + ro) = x0; *(f32x4*)((float*)xout + ro + 4) = x1; }
                    if (U) {
                        sq[ai][m] += (x0[0] * x0[0] + x0[1] * x0[1]) + (x0[2] * x0[2] + x0[3] * x0[3]) + (x1[0] * x1[0] + x1[1] * x1[1]) + (x1[2] * x1[2] + x1[3] * x1[3]);
                        const f32x4 y0 = x0 * gs0, y1 = x1 * gs1;
                        u32x4 w; w.x = cvt_pk_bf16(y0[0], y0[1]); w.y = cvt_pk_bf16(y0[2], y0[3]); w.z = cvt_pk_bf16(y1[0], y1[1]); w.w = cvt_pk_bf16(y1[2], y1[3]);
                        *(u32x4*)(U + ro) = w;
                    }
                }
            }
#undef ER_LOAD
        }
        if (U) {
#pragma unroll
            for (int ai = 0; ai < 2; ++ai)
#pragma unroll
                for (int m = 0; m < 4; ++m) { float s = sq[ai][m]; s += shfl_xor_f(s, 16); s += shfl_xor_f(s, 32); if (fq == 0) atomicAdd(ss + row0 + ai * 128 + m * 16, (unsigned long long)__float2ll_rn(s * 65536.0f)); }
        }
    }
};
struct EpiGates {
    static constexpr bool PERM = false;
    const bf16_t* XL; const bf16_t* XLc; bf16_t* LA; bf16_t* BX; bf16_t* LAc; bf16_t* BXc; const float* b_a; const float* b_i; const float* sp;
    HD void operator()(const f32x4 (&acc)[2][2][4][2], const Unit& u, int wr, int wc, int fr, int fq) const {
        const bool isctx = u.pm >= 128;
        const int head = u.pn >> 2, dir = (u.pn >> 1) & 1, half = u.pn & 1;
        const int row0 = (isctx ? (u.pm - 128) : u.pm) * 256 + wr * 64 + fr;
        if (isctx) body(acc, XLc, LAc + (size_t)dir * MC * 1024, BXc + (size_t)dir * MC * 1024, head, dir, half, row0, wc, fq);
        else body(acc, XL, LA + (size_t)dir * M * 1024, BX + (size_t)dir * M * 1024, head, dir, half, row0, wc, fq);
    }
    HD void body(const f32x4 (&acc)[2][2][4][2], const bf16_t* xb, bf16_t* la, bf16_t* bx, int head, int dir, int half, int row0, int wc, int fq) const {
#pragma unroll
        for (int bj = 0; bj < 2; ++bj) {
            const int chg = head * 256 + half * 128 + bj * 64 + wc * 16 + fq * 4;
            const f32x4 ba = *(const f32x4*)(b_a + dir * 1024 + chg), bi = *(const f32x4*)(b_i + dir * 1024 + chg), spv = *(const f32x4*)(sp + dir * 1024 + chg);
#pragma unroll
            for (int am = 0; am < 4; ++am) {
                u32x2 xrr[2];
#pragma unroll
                for (int r = 0; r < 2; ++r) xrr[r] = *(const u32x2*)(xb + (size_t)(row0 + (am >> 1) * 128 + (2 * (am & 1) + r) * 16) * 1024 + chg);
#pragma unroll
                for (int r = 0; r < 2; ++r) {
                    const int ai = am >> 1, m = 2 * (am & 1) + r;
                    const size_t o = (size_t)(row0 + ai * 128 + m * 16) * 1024 + chg;
                    const u32x2 xr = xrr[r];
                    const float xv[4] = {bf_lo(xr.x), bf_hi(xr.x), bf_lo(xr.y), bf_hi(xr.y)};
                    float lo[4], bo[4];
#pragma unroll
                    for (int j = 0; j < 4; ++j) {
                        const float r = fsigmoid(acc[ai][bj][m][0][j] + ba[j]), ig = fsigmoid(acc[ai][bj][m][1][j] + bi[j]);
                        const float l = -8.0f * r * spv[j], t2 = 2.0f * l;
                        const float om = (t2 > -0.05f) ? -t2 * (1.0f + t2 * (0.5f + t2 * (1.0f / 6.0f))) : 1.0f - __expf(t2);
                        lo[j] = l; bo[j] = __fsqrt_rn(fmaxf(om, 0.f)) * ig * xv[j];
                    }
                    u32x2 w; w.x = cvt_pk_bf16(lo[0], lo[1]); w.y = cvt_pk_bf16(lo[2], lo[3]); *(u32x2*)(la + o) = w;
                    w.x = cvt_pk_bf16(bo[0], bo[1]); w.y = cvt_pk_bf16(bo[2], bo[3]); *(u32x2*)(bx + o) = w;
                }
            }
        }
    }
};

HD float wave_sum(float v) {
#pragma unroll
    for (int o = 32; o >= 1; o >>= 1) v += shfl_xor_f(v, o);
    return v;
}
HD void wjob(const Params& p, int j, const float*& src, int& K, int& N, bf16_t*& dst, int& gate_id) {
    gate_id = -1;
    switch (j) {
        case 0: src = p.in[I_LWIN]; K = 1024; N = 2048; dst = (bf16_t*)(p.ws + W_IN0); break;
        case 1: src = p.in[I_LWO]; K = 1024; N = 1024; dst = (bf16_t*)(p.ws + W_OUT0); break;
        case 2: src = p.in[I_W1]; K = 1024; N = 4096; dst = (bf16_t*)(p.ws + W_M1_0); break;
        case 3: src = p.in[I_W2]; K = 4096; N = 1024; dst = (bf16_t*)(p.ws + W_M2_0); break;
        case 4: src = p.in[I_HWIN]; K = 1024; N = 3072; dst = (bf16_t*)(p.ws + W_HYIN); break;
        case 5: src = p.in[I_HWO]; K = 1024; N = 1024; dst = (bf16_t*)(p.ws + W_HYOUT); break;
        case 6: src = p.in[I_W1] + (size_t)1024 * 4096; K = 1024; N = 4096; dst = (bf16_t*)(p.ws + W_M1_1); break;
        case 7: src = p.in[I_W2] + (size_t)1024 * 4096; K = 4096; N = 1024; dst = (bf16_t*)(p.ws + W_M2_1); break;
        default: { const int id = j - 8, n = id & 1, dir = (id >> 1) & 1, head = id >> 2; gate_id = id;
            src = (n ? p.in[I_LWI] : p.in[I_LWA]) + (size_t)(dir * 4 + head) * 65536; K = 256; N = 256; dst = (bf16_t*)(p.ws + W_GATE); } break;
    }
}
HD void phase_prep(const Params& p, float* lds, bool do_mods) {
    int tid = ltid(); asm volatile("" : "+v"(tid)); const int bid = blockIdx.x, nb = gridDim.x;
    {
        const int ntiles[9] = {512, 256, 1024, 1024, 768, 256, 1024, 1024, 256};
        const int grp = tid >> 7, t = tid & 127;
        float* tl = lds + grp * (64 * 65);
#pragma unroll 1
        for (int it = bid; it < 6144 / 4; it += nb) {
            const int tI = it * 4 + grp;
            int j = 0, rem = tI;
#pragma unroll
            for (int q = 0; q < 8; ++q) if (j == q && rem >= ntiles[q]) { rem -= ntiles[q]; j = q + 1; }
            if (j == 8) { j = 8 + (rem >> 4); rem &= 15; }
            const float* src; int K, N, gid; bf16_t* dst; wjob(p, j, src, K, N, dst, gid);
            const int ntn = N / 64, k0 = (rem / ntn) * 64, n0 = (rem % ntn) * 64;
            { const int r = t >> 4, c4 = t & 15;
              f32x4 v[8];
#pragma unroll
              for (int ps = 0; ps < 8; ++ps) v[ps] = *(const f32x4*)(src + (size_t)(k0 + r + 8 * ps) * N + n0 + c4 * 4);
#pragma unroll
              for (int ps = 0; ps < 8; ++ps) { const int k = r + 8 * ps; tl[k * 65 + c4 * 4 + 0] = v[ps][0]; tl[k * 65 + c4 * 4 + 1] = v[ps][1]; tl[k * 65 + c4 * 4 + 2] = v[ps][2]; tl[k * 65 + c4 * 4 + 3] = v[ps][3]; } }
            __syncthreads();
            { const int nn = t >> 1, kh = t & 1;
              int drow = n0 + nn;
              if (gid >= 0) { const int n = gid & 1, dir = (gid >> 1) & 1, head = gid >> 2, jc = n0 + nn, half = jc >> 7, ch = jc & 127;
                  const int rho = ((ch >> 6) << 7) | (((ch >> 4) & 3) << 5) | (n << 4) | (ch & 15); drow = (head * 4 + dir * 2 + half) * 256 + rho; }
#pragma unroll
              for (int q8 = 0; q8 < 4; ++q8) { float v[8];
#pragma unroll
                  for (int q = 0; q < 8; ++q) v[q] = tl[(kh * 32 + q8 * 8 + q) * 65 + nn];
                  u32x4 w; w.x = cvt_pk_bf16(v[0], v[1]); w.y = cvt_pk_bf16(v[2], v[3]); w.z = cvt_pk_bf16(v[4], v[5]); w.w = cvt_pk_bf16(v[6], v[7]);
                  *(u32x4*)(dst + (size_t)drow * K + k0 + kh * 32 + q8 * 8) = w; } }
            __syncthreads();
        }
    }
    if (do_mods) {
        float* modp = (float*)(p.ws + OFF_MODP);
        const int gw = bid * 8 + (tid >> 6), nw = nb * 8, lane = tid & 63;
#pragma unroll 1
        for (int it = gw; it < 1536; it += nw) {
            const int kc = it & 31, cgp = (it >> 5) % 24, layer = it / (32 * 24);
            const int col = cgp * 256 + lane * 4;
            const float* wbase = p.in[I_ADAW] + (size_t)layer * 1024 * 6144 + col;
            f32x4 a[5];
#pragma unroll
            for (int v = 0; v < 5; ++v) a[v] = (f32x4){0.f, 0.f, 0.f, 0.f};
            if (kc == 0) { const f32x4 bv = *(const f32x4*)(p.in[I_ADAB] + layer * 6144 + col);
#pragma unroll
                for (int v = 0; v < 5; ++v) a[v] = bv; }
#pragma unroll 8
            for (int kk = 0; kk < 32; ++kk) {
                const int k = kc * 32 + kk;
                const f32x4 wv = *(const f32x4*)(wbase + (size_t)k * 6144);
#pragma unroll
                for (int v = 0; v < 5; ++v) { const float c = (v < 4) ? p.in[I_C][v * 1024 + k] : p.in[I_CCTX][k]; const float s = c * fsigmoid(c); a[v] += wv * s; }
            }
#pragma unroll
            for (int v = 0; v < 5; ++v) *(f32x4*)(modp + ((size_t)kc * 10 + layer * 5 + v) * 6144 + col) = a[v];
        }
    }
    const int gt = bid * NT + tid, ngt = nb * NT;
    for (int i = gt; i < 2048; i += ngt) { const float l = p.in[I_LAM][i]; const float x = __expf(-l); ((float*)(p.ws + OFF_SP))[i] = x * (1.0f - x * (0.5f - x * (0.33333334f - 0.25f * x))); }
    { bf16_t* o = (bf16_t*)(p.ws + OFF_FW4T);
      for (int i = gt; i < 4096 * 64; i += ngt) { const int n = i & 4095, f = i >> 12; const float w = p.in[I_FW4][(size_t)f * 4096 + n];
          const bf16_t h = f2bf(w); const bf16_t l = f2bf(w - bf2f(h)); bf16_t* r = o + (size_t)n * 256; r[f] = h; r[64 + f] = h; r[128 + f] = l; r[192 + f] = 0; } }
    {
        float* pos = lds; float* hA = lds + 8 * 33; float* hB = hA + 8 * 64;
        float* w1 = hB + 8 * 64; float* w2 = w1 + 33 * 64; float* w3 = w2 + 64 * 64;
        __syncthreads();
        for (int i = tid; i < 33 * 64; i += NT) w1[i] = p.in[I_FW1][i];
        for (int i = tid; i < 64 * 64; i += NT) { w2[i] = p.in[I_FW2][i]; w3[i] = p.in[I_FW3][i]; }
        const int tl = tid >> 6, f = tid & 63;
        const float fr = p.in[I_FREQ][f];
        bf16_t* o = (bf16_t*)(p.ws + OFF_BH3);
#pragma unroll 1
        for (int it = bid; it < 1024; it += nb) {
            const int ti = it * 8 + tl;
            __syncthreads();
            if (f < 33) {
                float v;
                if (f == 0) v = (float)ti * (1.0f / 8191.0f);
                else { const int j = (f - 1) & 15; const float band = 1e-4f + (float)j * ((15.0f - 1e-4f) / 15.0f); const float w = (6.283185307179586f / 8192.0f) * (float)ti;
                    v = (f <= 16) ? __cosf(band * w) : -__sinf(band * w); }
                pos[tl * 33 + f] = v;
            }
            __syncthreads();
            float a = p.in[I_FB1][f];
#pragma unroll 3
            for (int e = 0; e < 33; ++e) a += pos[tl * 33 + e] * w1[e * 64 + f];
            hA[tl * 64 + f] = __sinf(fr * a);
            __syncthreads();
            a = p.in[I_FB2][f];
#pragma unroll 8
            for (int e = 0; e < 64; ++e) a += hA[tl * 64 + e] * w2[e * 64 + f];
            hB[tl * 64 + f] = __sinf(fr * a);
            __syncthreads();
            a = p.in[I_FB3][f];
#pragma unroll 8
            for (int e = 0; e < 64; ++e) a += hB[tl * 64 + e] * w3[e * 64 + f];
            const float h = __sinf(fr * a);
            const bf16_t hh = f2bf(h); const bf16_t hl = f2bf(h - bf2f(hh));
            bf16_t* r = o + (size_t)ti * 256; r[f] = hh; r[64 + f] = hl; r[128 + f] = hh; r[192 + f] = 0;
        }
        __syncthreads();
    }
}
HD void phase_norm(const float* xmain, const float* xctx, int nrows, const float* g, const float* modl, int shc, int scc, bf16_t* Umain, bf16_t* Uctx) {
    const int lane = ltid() & 63, gw = blockIdx.x * 8 + (ltid() >> 6), nw = gridDim.x * 8;
#pragma unroll 1
    for (int rp = gw; rp < nrows / 2; rp += nw) {
        const int row = rp * 2;
        const bool isc = row >= M;
        const float* src = isc ? xctx + (size_t)(row - M) * 1024 : xmain + (size_t)row * 1024;
        const float* mv = modl + (isc ? 4 : (row >> 13)) * 6144;
        bf16_t* dst = isc ? Uctx + (size_t)(row - M) * 1024 : Umain + (size_t)row * 1024;
        f32x4 v[2][4];
#pragma unroll
        for (int r = 0; r < 2; ++r) { v[r][0] = *(const f32x4*)(src + r * 1024 + lane * 8); v[r][1] = *(const f32x4*)(src + r * 1024 + lane * 8 + 4);
            v[r][2] = *(const f32x4*)(src + r * 1024 + 512 + lane * 8); v[r][3] = *(const f32x4*)(src + r * 1024 + 512 + lane * 8 + 4); }
        float rstd[2];
#pragma unroll
        for (int r = 0; r < 2; ++r) { float ss = 0.f;
#pragma unroll
            for (int q = 0; q < 4; ++q) ss += v[r][q][0] * v[r][q][0] + v[r][q][1] * v[r][q][1] + v[r][q][2] * v[r][q][2] + v[r][q][3] * v[r][q][3];
            ss = wave_sum(ss); rstd[r] = rsqrtf(ss * (1.0f / 1024.0f) + 1e-6f); }
#pragma unroll
        for (int hf = 0; hf < 2; ++hf) {
            const int c = hf * 512 + lane * 8;
            float gs[8], sh[8];
#pragma unroll
            for (int q = 0; q < 2; ++q) {
                const f32x4 gg = *(const f32x4*)(g + c + q * 4), s4 = *(const f32x4*)(mv + shc * 1024 + c + q * 4), sc = *(const f32x4*)(mv + scc * 1024 + c + q * 4);
#pragma unroll
                for (int j = 0; j < 4; ++j) { gs[q * 4 + j] = gg[j] * (1.0f + sc[j]); sh[q * 4 + j] = s4[j]; }
            }
#pragma unroll
            for (int r = 0; r < 2; ++r) {
                float o[8];
#pragma unroll
                for (int q = 0; q < 2; ++q)
#pragma unroll
                    for (int j = 0; j < 4; ++j) o[q * 4 + j] = v[r][hf * 2 + q][j] * rstd[r] * gs[q * 4 + j] + sh[q * 4 + j];
                u32x4 w; w.x = cvt_pk_bf16(o[0], o[1]); w.y = cvt_pk_bf16(o[2], o[3]); w.z = cvt_pk_bf16(o[4], o[5]); w.w = cvt_pk_bf16(o[6], o[7]);
                *(u32x4*)(dst + r * 1024 + c) = w;
            }
        }
    }
}
HD void phase_shw(const Params& p) {
    const float* mod0 = (const float*)(p.ws + OFF_MOD); const float* mod1 = mod0 + 5 * 6144;
    float* shw = (float*)(p.ws + OFF_SHWP);
    const int lane = ltid() & 63, gw = blockIdx.x * 8 + (ltid() >> 6), nw = gridDim.x * 8;
#pragma unroll 1
    for (int it = gw; it < 44 * 32; it += nw) {
        const int kc = it & 31, cg = it >> 5;
        const float* W; const float* sh; float* o; int N, cgl;
        if (cg < 16) { W = p.in[I_W1]; sh = mod0 + 3 * 1024; o = shw; N = 4096; cgl = cg; }
        else if (cg < 28) { W = p.in[I_HWIN]; sh = mod1; o = shw + 4 * 4096; N = 3072; cgl = cg - 16; }
        else { W = p.in[I_W1] + (size_t)1024 * 4096; sh = mod1 + 3 * 1024; o = shw + 4 * 4096 + 4 * 3072; N = 4096; cgl = cg - 28; }
        const int col = cgl * 256 + lane * 4;
        f32x4 a[4];
#pragma unroll
        for (int v = 0; v < 4; ++v) a[v] = (f32x4){0.f, 0.f, 0.f, 0.f};
#pragma unroll 8
        for (int kk = 0; kk < 32; ++kk) {
            const int k = kc * 32 + kk;
            const f32x4 wv = *(const f32x4*)(W + (size_t)k * N + col);
#pragma unroll
            for (int v = 0; v < 4; ++v) a[v] += wv * sh[v * 6144 + k];
        }
#pragma unroll
        for (int v = 0; v < 4; ++v) *(f32x4*)(o + (size_t)kc * 45056 + (size_t)v * N + col) = a[v];
    }
}
HD void phase_final_norm(const bf16_t* xs, float* x, const float* g) {
    const int lane = ltid() & 63, gw = blockIdx.x * 8 + (ltid() >> 6), nw = gridDim.x * 8;
    f32x4 gg[4];
#pragma unroll
    for (int q = 0; q < 4; ++q) gg[q] = *(const f32x4*)(g + (q >> 1) * 512 + lane * 8 + (q & 1) * 4);
#pragma unroll 1
    for (int r4 = gw; r4 < M / 4; r4 += nw) {
        const bf16_t* src = xs + (size_t)r4 * 4096; float* dst = x + (size_t)r4 * 4096;
        u32x4 h[4][2];
#pragma unroll
        for (int r = 0; r < 4; ++r) { h[r][0] = *(const u32x4*)(src + r * 1024 + lane * 8); h[r][1] = *(const u32x4*)(src + r * 1024 + 512 + lane * 8); }
#pragma unroll
        for (int r = 0; r < 4; ++r) {
            f32x4 v[4];
#pragma unroll
            for (int hf = 0; hf < 2; ++hf) { const u32x4 t = h[r][hf]; v[hf * 2] = (f32x4){bf_lo(t.x), bf_hi(t.x), bf_lo(t.y), bf_hi(t.y)}; v[hf * 2 + 1] = (f32x4){bf_lo(t.z), bf_hi(t.z), bf_lo(t.w), bf_hi(t.w)}; }
            float ss = 0.f;
#pragma unroll
            for (int q = 0; q < 4; ++q) ss += v[q][0] * v[q][0] + v[q][1] * v[q][1] + v[q][2] * v[q][2] + v[q][3] * v[q][3];
            ss = wave_sum(ss);
            const float rstd = rsqrtf(ss * (1.0f / 1024.0f) + 1e-6f);
#pragma unroll
            for (int q = 0; q < 4; ++q) *(f32x4*)(dst + r * 1024 + (q >> 1) * 512 + lane * 8 + (q & 1) * 4) = v[q] * rstd * gg[q];
        }
    }
}
HD void phase_lru_conv(const Params& p) {
    const bf16_t* ZR = (const bf16_t*)(p.out) + (size_t)M * 1024;
    const bf16_t* ZRc = (const bf16_t*)(p.ws + OFF_ZRC);
    bf16_t* XL = (bf16_t*)(p.ws + OFF_U); bf16_t* XLc = (bf16_t*)(p.ws + OFF_UC);
    const float* cw = p.in[I_LCW]; const float* cb = p.in[I_LCB];
    const int gt = blockIdx.x * NT + ltid(), ngt = gridDim.x * NT;
    for (int idx = gt; idx < ((M + MC) / 16) * 128; idx += ngt) {
        const int cgp = idx & 127, seg = idx >> 7, c = cgp * 8;
        int t0 = seg * 16; const bf16_t* src; bf16_t* dst; int pos, rl;
        if (t0 < M) { src = ZR; dst = XL; pos = t0 & 63; rl = 64; } else { t0 -= M; src = ZRc; dst = XLc; pos = t0 & 255; rl = 256; }
        float w[4][8], bb[8];
#pragma unroll
        for (int k = 0; k < 4; ++k) { const f32x4 a = *(const f32x4*)(cw + k * 1024 + c), b = *(const f32x4*)(cw + k * 1024 + c + 4);
#pragma unroll
            for (int j = 0; j < 4; ++j) { w[k][j] = a[j]; w[k][4 + j] = b[j]; } }
        { const f32x4 a = *(const f32x4*)(cb + c), b = *(const f32x4*)(cb + c + 4);
#pragma unroll
          for (int j = 0; j < 4; ++j) { bb[j] = a[j]; bb[4 + j] = b[j]; } }
        u32x4 win[4];
#pragma unroll
        for (int q = 0; q < 3; ++q) { const int dt = q - 2, pp = pos + dt; win[q + 1] = (pp >= 0 && pp < rl) ? *(const u32x4*)(src + (size_t)(t0 + dt) * 1024 + c) : (u32x4){0u, 0u, 0u, 0u}; }
#pragma unroll
        for (int i = 0; i < 16; ++i) {
            win[0] = win[1]; win[1] = win[2]; win[2] = win[3];
            { const int pp = pos + i + 1; win[3] = (pp < rl) ? *(const u32x4*)(src + (size_t)(t0 + i + 1) * 1024 + c) : (u32x4){0u, 0u, 0u, 0u}; }
            float o[8];
#pragma unroll
            for (int j = 0; j < 8; ++j) o[j] = bb[j];
#pragma unroll
            for (int k = 0; k < 4; ++k) {
                const u32x4 r = win[k];
                o[0] += w[k][0] * bf_lo(r.x); o[1] += w[k][1] * bf_hi(r.x); o[2] += w[k][2] * bf_lo(r.y); o[3] += w[k][3] * bf_hi(r.y);
                o[4] += w[k][4] * bf_lo(r.z); o[5] += w[k][5] * bf_hi(r.z); o[6] += w[k][6] * bf_lo(r.w); o[7] += w[k][7] * bf_hi(r.w);
            }
            u32x4 wv; wv.x = cvt_pk_bf16(o[0], o[1]); wv.y = cvt_pk_bf16(o[2], o[3]); wv.z = cvt_pk_bf16(o[4], o[5]); wv.w = cvt_pk_bf16(o[6], o[7]);
            *(u32x4*)(dst + (size_t)(t0 + i) * 1024 + c) = wv;
        }
    }
}
HD void phase_scan_sum(const Params& p) {
    const int gt = blockIdx.x * NT + ltid(), ngt = gridDim.x * NT;
    float* SA = (float*)(p.ws + OFF_SUMA); float* SH = (float*)(p.ws + OFF_SUMH);
    for (int idx = gt; idx < 128 * 2 * 528; idx += ngt) {
        const int c = (idx & 127) * 8, rest = idx >> 7, dir = rest & 1, chunk = rest >> 1;
        const bf16_t* la; const bf16_t* bx; int b, slot; size_t r0;
        if (chunk < 512) { b = chunk >> 7; const int cc = chunk & 127; slot = 4 + cc; r0 = (size_t)b * 8192 + cc * 64;
            la = (const bf16_t*)(p.ws + OFF_LA) + (size_t)dir * M * 1024; bx = (const bf16_t*)(p.ws + OFF_BX) + (size_t)dir * M * 1024; }
        else { const int q = chunk - 512; b = q >> 2; const int cc = q & 3; slot = cc; r0 = (size_t)b * 256 + cc * 64;
            la = (const bf16_t*)(p.ws + OFF_LAC) + (size_t)dir * MC * 1024; bx = (const bf16_t*)(p.ws + OFF_BXC) + (size_t)dir * MC * 1024; }
        float A[8], H[8];
#pragma unroll
        for (int j = 0; j < 8; ++j) { A[j] = 0.f; H[j] = 0.f; }
#pragma unroll 16
        for (int i = 0; i < 64; ++i) {
            const int t = dir ? 63 - i : i;
            const u32x4 l = *(const u32x4*)(la + (r0 + t) * 1024 + c), x = *(const u32x4*)(bx + (r0 + t) * 1024 + c);
            const float lv[8] = {bf_lo(l.x), bf_hi(l.x), bf_lo(l.y), bf_hi(l.y), bf_lo(l.z), bf_hi(l.z), bf_lo(l.w), bf_hi(l.w)};
            const float xv[8] = {bf_lo(x.x), bf_hi(x.x), bf_lo(x.y), bf_hi(x.y), bf_lo(x.z), bf_hi(x.z), bf_lo(x.w), bf_hi(x.w)};
#pragma unroll
            for (int j = 0; j < 8; ++j) { A[j] += lv[j]; H[j] = __expf(lv[j]) * H[j] + xv[j]; }
        }
        const size_t o = ((size_t)(dir * 4 + b) * 132 + slot) * 1024 + c;
        *(f32x4*)(SA + o) = (f32x4){A[0], A[1], A[2], A[3]}; *(f32x4*)(SA + o + 4) = (f32x4){A[4], A[5], A[6], A[7]};
        *(f32x4*)(SH + o) = (f32x4){H[0], H[1], H[2], H[3]}; *(f32x4*)(SH + o + 4) = (f32x4){H[4], H[5], H[6], H[7]};
    }
}
HD void phase_scan_final(const Params& p) {
    const int gt = blockIdx.x * NT + ltid(), ngt = gridDim.x * NT;
    const float* SA = (const float*)(p.ws + OFF_SUMA); const float* SH = (const float*)(p.ws + OFF_SUMH);
    const bf16_t* LA0 = (const bf16_t*)(p.ws + OFF_LA); const bf16_t* LA1 = LA0 + (size_t)M * 1024;
    const bf16_t* BX0 = (const bf16_t*)(p.ws + OFF_BX); const bf16_t* BX1 = BX0 + (size_t)M * 1024;
    const bf16_t* G = (const bf16_t*)(p.out);
    bf16_t* HG = (bf16_t*)(p.ws + OFF_HG);
    for (int idx = gt; idx < 4 * 128 * 256; idx += ngt) {
        const int c = (idx & 255) * 4, rest = idx >> 8, cc = rest & 127, b = rest >> 7;
        f32x4 hf = (f32x4){0.f, 0.f, 0.f, 0.f}, hb = hf;
#define SC_STEP(st, av, hv) { _Pragma("unroll") for (int j = 0; j < 4; ++j) st[j] = __expf(av[j]) * st[j] + hv[j]; }
        { const float* a = SA + ((size_t)(0 * 4 + b) * 132) * 1024 + c; const float* h = SH + ((size_t)(0 * 4 + b) * 132) * 1024 + c;
          const int n = 4 + cc; int s = 0;
#pragma unroll 1
          for (; s + 8 <= n; s += 8) { f32x4 av[8], hv[8];
#pragma unroll
              for (int q = 0; q < 8; ++q) { av[q] = *(const f32x4*)(a + (size_t)(s + q) * 1024); hv[q] = *(const f32x4*)(h + (size_t)(s + q) * 1024); }
#pragma unroll
              for (int q = 0; q < 8; ++q) SC_STEP(hf, av[q], hv[q]) }
#pragma unroll 1
          for (; s < n; ++s) { const f32x4 av = *(const f32x4*)(a + (size_t)s * 1024), hv = *(const f32x4*)(h + (size_t)s * 1024); SC_STEP(hf, av, hv) } }
        { const float* a = SA + ((size_t)(1 * 4 + b) * 132) * 1024 + c; const float* h = SH + ((size_t)(1 * 4 + b) * 132) * 1024 + c;
          { f32x4 av[4], hv[4];
#pragma unroll
            for (int q = 0; q < 4; ++q) { av[q] = *(const f32x4*)(a + (size_t)(3 - q) * 1024); hv[q] = *(const f32x4*)(h + (size_t)(3 - q) * 1024); }
#pragma unroll
            for (int q = 0; q < 4; ++q) SC_STEP(hb, av[q], hv[q]) }
          const int lo = 4 + cc; int s = 131;
#pragma unroll 1
          for (; s - 8 >= lo; s -= 8) { f32x4 av[8], hv[8];
#pragma unroll
              for (int q = 0; q < 8; ++q) { av[q] = *(const f32x4*)(a + (size_t)(s - q) * 1024); hv[q] = *(const f32x4*)(h + (size_t)(s - q) * 1024); }
#pragma unroll
              for (int q = 0; q < 8; ++q) SC_STEP(hb, av[q], hv[q]) }
#pragma unroll 1
          for (; s > lo; --s) { const f32x4 av = *(const f32x4*)(a + (size_t)s * 1024), hv = *(const f32x4*)(h + (size_t)s * 1024); SC_STEP(hb, av, hv) } }
#undef SC_STEP
        const size_t r0 = ((size_t)b * 8192 + cc * 64) * 1024 + c;
        unsigned hs[64][2];
#pragma unroll
        for (int i = 0; i < 64; ++i) {
            const u32x2 l = *(const u32x2*)(LA0 + r0 + (size_t)i * 1024), x = *(const u32x2*)(BX0 + r0 + (size_t)i * 1024);
            hf[0] = __expf(bf_lo(l.x)) * hf[0] + bf_lo(x.x); hf[1] = __expf(bf_hi(l.x)) * hf[1] + bf_hi(x.x);
            hf[2] = __expf(bf_lo(l.y)) * hf[2] + bf_lo(x.y); hf[3] = __expf(bf_hi(l.y)) * hf[3] + bf_hi(x.y);
            hs[i][0] = cvt_pk_bf16(hf[0], hf[1]); hs[i][1] = cvt_pk_bf16(hf[2], hf[3]);
        }
#pragma unroll
        for (int i = 63; i >= 0; --i) {
            const u32x2 l = *(const u32x2*)(LA1 + r0 + (size_t)i * 1024), x = *(const u32x2*)(BX1 + r0 + (size_t)i * 1024), gg = *(const u32x2*)(G + r0 + (size_t)i * 1024);
            hb[0] = __expf(bf_lo(l.x)) * hb[0] + bf_lo(x.x); hb[1] = __expf(bf_hi(l.x)) * hb[1] + bf_hi(x.x);
            hb[2] = __expf(bf_lo(l.y)) * hb[2] + bf_lo(x.y); hb[3] = __expf(bf_hi(l.y)) * hb[3] + bf_hi(x.y);
            u32x2 w;
            w.x = cvt_pk_bf16((bf_lo(hs[i][0]) + hb[0]) * bf_lo(gg.x), (bf_hi(hs[i][0]) + hb[1]) * bf_hi(gg.x));
            w.y = cvt_pk_bf16((bf_lo(hs[i][1]) + hb[2]) * bf_lo(gg.y), (bf_hi(hs[i][1]) + hb[3]) * bf_hi(gg.y));
            *(u32x2*)(HG + r0 + (size_t)i * 1024) = w;
        }
    }
}
HD void phase_hy_conv_T(const Params& p, unsigned* lds) {
    const bf16_t* Z3 = (const bf16_t*)(p.ws + OFF_Z3); bf16_t* T = (bf16_t*)(p.ws + OFF_T);
    const float* cw = p.in[I_HCW]; const float* cb = p.in[I_HCB];
    int tid = ltid(); asm volatile("" : "+v"(tid));
    u32x4 pre[4];
    { const int it0 = blockIdx.x; if (it0 < 256 * 24) { const int row = tid >> 4, c8 = tid & 15;
#pragma unroll
        for (int ps = 0; ps < 4; ++ps) pre[ps] = *(const u32x4*)(Z3 + (size_t)((it0 / 24) * 128 + row + 32 * ps) * 3072 + (it0 % 24) * 128 + c8 * 8); } }
#pragma unroll 1
    for (int it = blockIdx.x; it < 256 * 24; it += gridDim.x) {
        const int ct = it % 24, tt = it / 24, c0 = ct * 128, t0 = tt * 128;
        __syncthreads();
        { const int row = tid >> 4, c8 = tid & 15;
#pragma unroll
          for (int ps = 0; ps < 4; ++ps) { const int t = row + 32 * ps; *(u32x4*)(lds + t * 64 + ((c8 * 4 + 4 * (t >> 3)) & 63)) = pre[ps]; }
          const int itn = it + gridDim.x;
          if (itn < 256 * 24) {
#pragma unroll
              for (int ps = 0; ps < 4; ++ps) pre[ps] = *(const u32x4*)(Z3 + (size_t)((itn / 24) * 128 + row + 32 * ps) * 3072 + (itn % 24) * 128 + c8 * 8); } }
        __syncthreads();
#pragma unroll
        for (int k = 0; k < 2; ++k) {
            const int item = tid + 512 * k, tg = item & 15, cp = item >> 4, gc = c0 + 2 * cp;
            float w0[3], w1[3];
#pragma unroll
            for (int q = 0; q < 3; ++q) { const f32x2 wv = *(const f32x2*)(cw + q * 3072 + gc); w0[q] = wv.x; w1[q] = wv.y; }
            const f32x2 bv = *(const f32x2*)(cb + gc);
            float z0[10], z1[10];
#pragma unroll
            for (int j = 0; j < 10; ++j) {
                const int t = 8 * tg + j - 1;
                const bool ok = (t >= 0) && (t < 128) && ((t >> 6) == (tg >> 3));
                const unsigned dw = ok ? lds[t * 64 + ((cp + 4 * (t >> 3)) & 63)] : 0u;
                z0[j] = bf_lo(dw); z1[j] = bf_hi(dw);
            }
            float o0[8], o1[8];
#pragma unroll
            for (int j = 0; j < 8; ++j) { o0[j] = bv.x + w0[0] * z0[j] + w0[1] * z0[j + 1] + w0[2] * z0[j + 2]; o1[j] = bv.y + w1[0] * z1[j] + w1[1] * z1[j + 1] + w1[2] * z1[j + 2]; }
            const int which = gc >> 10, d = gc & 1023, row = t0 + 8 * tg, b = row >> 13, t = row & 8191;
            bf16_t* dst = T + (((size_t)(which * 4 + b) * 1024 + d) * 8192 + t);
            u32x4 w; w.x = cvt_pk_bf16(o0[0], o0[1]); w.y = cvt_pk_bf16(o0[2], o0[3]); w.z = cvt_pk_bf16(o0[4], o0[5]); w.w = cvt_pk_bf16(o0[6], o0[7]);
            *(u32x4*)dst = w;
            w.x = cvt_pk_bf16(o1[0], o1[1]); w.y = cvt_pk_bf16(o1[2], o1[3]); w.z = cvt_pk_bf16(o1[4], o1[5]); w.w = cvt_pk_bf16(o1[6], o1[7]);
            *(u32x4*)(dst + 8192) = w;
        }
    }
    __syncthreads();
}
HD void phase_T_back(const Params& p, unsigned* lds) {
    const bf16_t* VT = (const bf16_t*)(p.ws + OFF_T); bf16_t* Y2 = (bf16_t*)(p.ws + OFF_Y2);
    int tid = ltid(); asm volatile("" : "+v"(tid));
    u32x4 pre[4];
    { const int it0 = blockIdx.x; if (it0 < 2048) { const int row = tid >> 4, t8 = tid & 15, dt = it0 & 7, tt = it0 >> 3, b = tt >> 6, t0 = (tt & 63) * 128, d0 = dt * 128;
#pragma unroll
        for (int ps = 0; ps < 4; ++ps) pre[ps] = *(const u32x4*)(VT + ((size_t)(b * 1024 + d0 + row + 32 * ps) * 8192 + t0 + t8 * 8)); } }
#pragma unroll 1
    for (int it = blockIdx.x; it < 2048; it += gridDim.x) {
        const int dt = it & 7, tt = it >> 3, b = tt >> 6, t0 = (tt & 63) * 128, d0 = dt * 128;
        __syncthreads();
        { const int row = tid >> 4, t8 = tid & 15;
#pragma unroll
          for (int ps = 0; ps < 4; ++ps) { const int dl = row + 32 * ps; *(u32x4*)(lds + dl * 64 + ((t8 * 4 + 4 * (dl >> 3)) & 63)) = pre[ps]; }
          const int itn = it + gridDim.x;
          if (itn < 2048) { const int dtn = itn & 7, ttn = itn >> 3, bn = ttn >> 6, t0n = (ttn & 63) * 128, d0n = dtn * 128;
#pragma unroll
              for (int ps = 0; ps < 4; ++ps) pre[ps] = *(const u32x4*)(VT + ((size_t)(bn * 1024 + d0n + row + 32 * ps) * 8192 + t0n + t8 * 8)); } }
        __syncthreads();
#pragma unroll
        for (int k = 0; k < 2; ++k) {
            const int item = tid + 512 * k, dg = item & 15, tp = item >> 4;
            unsigned v[8];
#pragma unroll
            for (int j = 0; j < 8; ++j) v[j] = lds[(8 * dg + j) * 64 + ((tp + 4 * dg) & 63)];
            u32x4 lo, hi;
            lo.x = (v[0] & 0xffffu) | (v[1] << 16); lo.y = (v[2] & 0xffffu) | (v[3] << 16); lo.z = (v[4] & 0xffffu) | (v[5] << 16); lo.w = (v[6] & 0xffffu) | (v[7] << 16);
            hi.x = (v[0] >> 16) | (v[1] & 0xffff0000u); hi.y = (v[2] >> 16) | (v[3] & 0xffff0000u); hi.z = (v[4] >> 16) | (v[5] & 0xffff0000u); hi.w = (v[6] >> 16) | (v[7] & 0xffff0000u);
            bf16_t* dst = Y2 + ((size_t)(b * 8192 + t0 + 2 * tp) * 1024 + d0 + 8 * dg);
            *(u32x4*)dst = lo; *(u32x4*)(dst + 1024) = hi;
        }
    }
    __syncthreads();
}
HD float block_sum(float v, float* red) {
    v = wave_sum(v);
    __syncthreads();
    if ((ltid() & 63) == 0) red[ltid() >> 6] = v;
    __syncthreads();
    float s = 0.f;
#pragma unroll
    for (int i = 0; i < 8; ++i) s += red[i];
    return s;
}
HD void phase_fft(const Params& p, float* re, float* im, float* red, bool do_store) {
    int tid = ltid();
    const bf16_t* HR = (const bf16_t*)(p.ws + OFF_HRAW);
    bf16_t* T = (bf16_t*)(p.ws + OFF_T);
    float* spec = (float*)(p.ws + OFF_SPEC + (size_t)blockIdx.x * 262144);
#pragma unroll 1
    for (int ch = blockIdx.x; ch < 1024; ch += gridDim.x) {
        OPAQUE(tid);
        const float kdec = -(3.0701134573253944f + (float)ch * (12.280453829301579f / 1023.0f)) * (1.0f / 8191.0f), rdec = __expf(kdec);
        {
            const bf16_t* h00 = HR + (size_t)(0 * 1024 + ch) * 8192; const bf16_t* h01 = HR + (size_t)(1 * 1024 + ch) * 8192;
            const bf16_t* h10 = HR + (size_t)(2 * 1024 + ch) * 8192; const bf16_t* h11 = HR + (size_t)(3 * 1024 + ch) * 8192;
            float s0 = 0.f, s1 = 0.f;
            unsigned t00[8], t10[8], t01[8], t11[8];
#pragma unroll
            for (int j = 0; j < 8; ++j) { const int n = 2 * (tid + 512 * j); t00[j] = *(const unsigned*)(h00 + n); t10[j] = *(const unsigned*)(h10 + n); t01[j] = *(const unsigned*)(h01 + n); t11[j] = *(const unsigned*)(h11 + n); }
#pragma unroll
            for (int j = 0; j < 8; ++j) { const int n = 2 * (tid + 512 * j);
                const unsigned u00 = t00[j], u10 = t10[j], u01 = t01[j], u11 = t11[j];
                const float e0 = __expf(kdec * (float)n), e1 = e0 * rdec;
                s0 += (fabsf(bf_lo(u00)) + fabsf(bf_lo(u10))) * e0 + (fabsf(bf_hi(u00)) + fabsf(bf_hi(u10))) * e1;
                s1 += (fabsf(bf_lo(u01)) + fabsf(bf_lo(u11))) * e0 + (fabsf(bf_hi(u01)) + fabsf(bf_hi(u11))) * e1; }
            s0 = block_sum(s0, red);
            s1 = block_sum(s1, red);
            const float inv0 = 1.0f / s0, inv1 = 1.0f / s1;
#pragma unroll
            for (int j = 0; j < 8; ++j) { const int n = 2 * (tid + 512 * j);
                const unsigned u00 = t00[j], u10 = t10[j], u01 = t01[j], u11 = t11[j];
                const float e0 = __expf(kdec * (float)n), e1 = e0 * rdec;
                const float a0 = e0 * inv0, a1 = e1 * inv0, b0 = e0 * inv1, b1 = e1 * inv1;
                if (n == 0) { re[PIX(0)] = (bf_lo(u00) + bf_lo(u10)) * a0; im[PIX(0)] = (bf_lo(u01) + bf_lo(u11)) * b0; re[PIX(8192)] = 0.f; im[PIX(8192)] = 0.f; }
                else { re[PIX(n)] = bf_lo(u00) * a0; im[PIX(n)] = bf_lo(u01) * b0; re[PIX(16384 - n)] = bf_lo(u10) * a0; im[PIX(16384 - n)] = bf_lo(u11) * b0; }
                re[PIX(n + 1)] = bf_hi(u00) * a1; im[PIX(n + 1)] = bf_hi(u01) * b1; re[PIX(16383 - n)] = bf_hi(u10) * a1; im[PIX(16383 - n)] = bf_hi(u11) * b1; }
            __syncthreads();
            fft_pass16<1024, false, false>(re, im, ltid()); __syncthreads();
            fft_pass16<64, false, false>(re, im, ltid()); __syncthreads();
            fft_pass16<4, false, false>(re, im, ltid()); __syncthreads();
            fft_r4_fwd_inplace(re, im, ltid()); __syncthreads();
            fft_hermitian_unpack(re, im, spec, spec + 32768, 1.0f / 16384.0f, ltid());
            __syncthreads();
        }
        const float sk0 = p.in[I_SKIP][ch], sk1 = p.in[I_SKIP][1024 + ch];
#pragma unroll 1
        for (int pr = 0; pr < 2; ++pr) {
            OPAQUE(tid);
            bf16_t* vb0 = T + ((size_t)(0 * 4 + 2 * pr) * 1024 + ch) * 8192; bf16_t* vb1 = vb0 + (size_t)1024 * 8192;
            const bf16_t* x1b0 = vb0 + (size_t)4 * 1024 * 8192; const bf16_t* x1b1 = x1b0 + (size_t)1024 * 8192;
            const bf16_t* x2b0 = x1b0 + (size_t)4 * 1024 * 8192; const bf16_t* x2b1 = x2b0 + (size_t)1024 * 8192;
            unsigned vr0[8], vr1[8], ar0[8], ar1[8];
#pragma unroll
            for (int j = 0; j < 8; ++j) { const int n = 2 * (tid + 512 * j); vr0[j] = *(const unsigned*)(vb0 + n); vr1[j] = *(const unsigned*)(vb1 + n); }
#pragma unroll
            for (int j = 0; j < 8; ++j) { const int n = 2 * (tid + 512 * j); ar0[j] = *(const unsigned*)(x1b0 + n); ar1[j] = *(const unsigned*)(x1b1 + n); }
#pragma unroll
            for (int j = 0; j < 8; ++j) { const int n = 2 * (tid + 512 * j);
                *(v2*)(re + PIX(n)) = v2{bf_lo(vr0[j]), bf_hi(vr0[j])}; *(v2*)(im + PIX(n)) = v2{bf_lo(vr1[j]), bf_hi(vr1[j])}; }
            __syncthreads();
            fft_pass16<1024, false, true>(re, im, ltid()); __syncthreads();
            fft_pass16<64, false, false>(re, im, ltid()); __syncthreads();
            fft_pass16<4, false, false>(re, im, ltid()); __syncthreads();
            fft_r4<1>(re, im, spec, spec + 16384, 0.f, ltid()); __syncthreads();
            fft_pass16<4, true, false>(re, im, ltid()); __syncthreads();
            fft_pass16<64, true, false>(re, im, ltid()); __syncthreads();
            fft_pass16<1024, true, true>(re, im, ltid()); __syncthreads();
#pragma unroll
            for (int j = 0; j < 8; ++j) { const int n = 2 * (tid + 512 * j);
                const v2 y0 = *(const v2*)(re + PIX(n)), y1 = *(const v2*)(im + PIX(n));
                const float r00 = bf_lo(ar0[j]) * (y0.x + bf_lo(vr0[j]) * sk0), r01 = bf_hi(ar0[j]) * (y0.y + bf_hi(vr0[j]) * sk0);
                const float r10 = bf_lo(ar1[j]) * (y1.x + bf_lo(vr1[j]) * sk0), r11 = bf_hi(ar1[j]) * (y1.y + bf_hi(vr1[j]) * sk0);
                *(v2*)(re + PIX(n)) = v2{r00, r01}; *(v2*)(im + PIX(n)) = v2{r10, r11};
                vr0[j] = cvt_pk_bf16(r00, r01); vr1[j] = cvt_pk_bf16(r10, r11); }
#pragma unroll
            for (int j = 0; j < 8; ++j) { const int n = 2 * (tid + 512 * j); ar0[j] = *(const unsigned*)(x2b0 + n); ar1[j] = *(const unsigned*)(x2b1 + n); }
            __syncthreads();
            fft_pass16<1024, false, true>(re, im, ltid()); __syncthreads();
            fft_pass16<64, false, false>(re, im, ltid()); __syncthreads();
            fft_pass16<4, false, false>(re, im, ltid()); __syncthreads();
            fft_r4<1>(re, im, spec + 32768, spec + 32768 + 16384, 0.f, ltid()); __syncthreads();
            fft_pass16<4, true, false>(re, im, ltid()); __syncthreads();
            fft_pass16<64, true, false>(re, im, ltid()); __syncthreads();
            fft_pass16<1024, true, true>(re, im, ltid()); __syncthreads();
#pragma unroll
            for (int j = 0; j < 8; ++j) { const int n = 2 * (tid + 512 * j);
                const v2 y0 = *(const v2*)(re + PIX(n)), y1 = *(const v2*)(im + PIX(n));
                const float r00 = bf_lo(ar0[j]) * (y0.x + bf_lo(vr0[j]) * sk1), r01 = bf_hi(ar0[j]) * (y0.y + bf_hi(vr0[j]) * sk1);
                const float r10 = bf_lo(ar1[j]) * (y1.x + bf_lo(vr1[j]) * sk1), r11 = bf_hi(ar1[j]) * (y1.y + bf_hi(vr1[j]) * sk1);
                if (do_store) { *(unsigned*)(vb0 + n) = cvt_pk_bf16(r00, r01); *(unsigned*)(vb1 + n) = cvt_pk_bf16(r10, r11); } }
            __syncthreads();
        }
    }
}

HD void phase_sum_partials(const float* src, float* dst, int n) {
    for (int i = blockIdx.x * NT + ltid(); i < n / 4; i += gridDim.x * NT) {
        f32x4 s = *(const f32x4*)(src + (size_t)i * 4);
#pragma unroll 8
        for (int c = 1; c < 32; ++c) s += *(const f32x4*)(src + (size_t)c * n + (size_t)i * 4);
        *(f32x4*)(dst + (size_t)i * 4) = s;
    }
}
constexpr int N_PHASES = 22;
constexpr unsigned SKIPMASK = (1u << 8) | (1u << 11) | (1u << 17);
#ifndef PHMASK
#define PHMASK 0xffffffffu
#endif
#define PH_EN(n) (((PHMASK) >> (n)) & 1u)
__global__ void __launch_bounds__(512, 2) mega(Params p) {
    extern __shared__ __attribute__((aligned(16))) unsigned char shm[];
    cg::grid_group grid = cg::this_grid();
    LAS unsigned char* lds = (LAS unsigned char*)shm;
    unsigned char* ws = p.ws;
    const float* mod0 = (const float*)(ws + OFF_MOD); const float* mod1 = mod0 + 5 * 6144;
    unsigned long long* ss = (unsigned long long*)(ws + OFF_SSI); const float* shw = (const float*)(ws + OFF_SHW);
    volatile LAS unsigned* xst = (volatile LAS unsigned*)(lds + LDS_BYTES - 16);
    if (threadIdx.x == 0) { xst[0] = 0u; xst[1] = 0u; }
    __syncthreads();
    (void)xcd_barrier_post((unsigned*)(ws + OFF_BAR), xst);
    if (p.ph_lo < 0) grid.sync();
#ifndef REPMASK
#define REPMASK 0u
#endif
#if (REPMASK >> 14) & 1
#define FFT_STORE(pq) (((pq) & 1) != 0)
#else
#define FFT_STORE(pq) true
#endif
#ifdef EXTRA_SYNCS
#pragma unroll 1
    for (int i = 0; i < EXTRA_SYNCS; ++i) grid.sync();
#endif
    for (int pq = 2 * p.ph_lo; pq < 2 * p.ph_hi; ++pq) {
        const int kq = pq >> 1, ph = kq == 0 ? 0 : (kq == 1 ? 21 : kq - 1);
        if ((SKIPMASK >> ph) & 1u) continue;
        if ((pq & 1) && !(((REPMASK) >> ph) & 1u)) continue;
        if (pq > 2 * p.ph_lo) { XcdBarrier xb; xb.bar = (unsigned*)(p.ws + OFF_BAR); xb.x = xb_xcc_id(); xb.st = (volatile LAS unsigned*)((LAS unsigned char*)shm + LDS_BYTES - 16); xcd_barrier(xb); }
        switch (ph) {
        case 0: if (PH_EN(0)) phase_prep(p, (float*)shm, !(pq & 1)); break;
        case 1: if (PH_EN(1)) { phase_norm(p.in[I_X], p.in[I_CTX], M + MC, p.in[I_NORMG], mod0, 0, 1, (bf16_t*)(ws + OFF_U), (bf16_t*)(ws + OFF_UC)); if (!(pq & 1)) phase_shw(p); } break;
        case 2: if (PH_EN(2)) { pg8::Gemm g{(const char*)(ws + OFF_U), (const char*)(ws + OFF_UC), (const char*)(ws + W_IN0), 1024, 1024, 1024, 132, 8, 128, 0, 0};
            EpiIn0 E{(bf16_t*)p.out, (bf16_t*)p.out + (size_t)M * 1024, (bf16_t*)(ws + OFF_ZRC), p.in[I_LBIN]}; pg8::gemm_phase(lds, g, E); } break;
        case 3: if (PH_EN(3)) { if (!(pq & 1)) phase_sum_partials((const float*)(ws + OFF_SHWP), (float*)(ws + OFF_SHW), 45056); phase_lru_conv(p); } break;
        case 4: if (PH_EN(4)) { pg8::Gemm g{(const char*)(ws + OFF_U), (const char*)(ws + OFF_UC), (const char*)(ws + W_GATE), 1024, 256, 256, 132, 16, 128, 2, 512};
            EpiGates E{(const bf16_t*)(ws + OFF_U), (const bf16_t*)(ws + OFF_UC), (bf16_t*)(ws + OFF_LA), (bf16_t*)(ws + OFF_BX), (bf16_t*)(ws + OFF_LAC), (bf16_t*)(ws + OFF_BXC),
                       p.in[I_LBA], p.in[I_LBI], (const float*)(ws + OFF_SP)}; pg8::gemm_phase(lds, g, E); } break;
        case 5: if (PH_EN(5)) phase_scan_sum(p); break;
        case 6: if (PH_EN(6)) phase_scan_final(p); break;
        case 7: if (PH_EN(7)) { pg8::Gemm g{(const char*)(ws + OFF_HG), nullptr, (const char*)(ws + W_OUT0), 1024, 1024, 1024, 128, 4, 1 << 30, 0, 0};
            EpiRes<2, false, true> E{p.in[I_X], p.out, mod0 + 2 * 1024, p.in[I_LBO], (bf16_t*)(ws + OFF_U), p.in[I_NORMG] + 1024, mod0 + 4 * 1024, ss}; pg8::gemm_phase(lds, g, E); } break;
        case 8: if (PH_EN(8)) phase_norm(p.out, nullptr, M, p.in[I_NORMG] + 1024, mod0, 3, 4, (bf16_t*)(ws + OFF_U), nullptr); break;
        case 9: if (PH_EN(9)) { pg8::Gemm g{(const char*)(ws + OFF_U), nullptr, (const char*)(ws + W_M1_0), 1024, 1024, 1024, 128, 16, 1 << 30, 0, 0};
            EpiBf16 E{(bf16_t*)(ws + OFF_H), 4096, nullptr, 1, ss, shw}; pg8::gemm_phase(lds, g, E); } break;
        case 10: if (PH_EN(10)) { pg8::Gemm g{(const char*)(ws + OFF_H), nullptr, (const char*)(ws + W_M2_0), 4096, 4096, 4096, 128, 4, 1 << 30, 0, 0};
            EpiRes<6, true, true> E{p.out, p.out, mod0 + 5 * 1024, nullptr, (bf16_t*)(ws + OFF_U), p.in[I_NORMG] + 2048, mod1 + 1 * 1024, ss + M}; pg8::gemm_phase(lds, g, E); } break;
        case 11: if (PH_EN(11)) phase_norm(p.out, nullptr, M, p.in[I_NORMG] + 2048, mod1, 0, 1, (bf16_t*)(ws + OFF_U), nullptr); break;
        case 12: if (PH_EN(12)) { pg8::Gemm g{(const char*)(ws + OFF_U), nullptr, (const char*)(ws + W_HYIN), 1024, 1024, 1024, 128, 12, 1 << 30, 0, 0};
            EpiBf16 E{(bf16_t*)(ws + OFF_Z3), 3072, p.in[I_HBIN], 0, ss + M, shw + 4 * 4096}; pg8::gemm_phase(lds, g, E); } break;
        case 13: if (PH_EN(13)) { pg8::Gemm g{(const char*)(ws + OFF_FW4T), nullptr, (const char*)(ws + OFF_BH3), 256, 256, 256, 16, 32, 1 << 30, 0, 0};
            EpiBf16 E{(bf16_t*)(ws + OFF_HRAW), 8192, nullptr, 0, nullptr, nullptr}; pg8::gemm_phase(lds, g, E);

#ifndef NO_CONVT
            phase_hy_conv_T(p, (unsigned*)shm);
#endif
            } break;
        case 14: if (PH_EN(14)) phase_fft(p, (float*)shm, (float*)shm + FFT_PLANE, (float*)shm + 2 * FFT_PLANE, FFT_STORE(pq)); break;
        case 15: if (PH_EN(15)) phase_T_back(p, (unsigned*)shm); break;
        case 16: if (PH_EN(16)) { pg8::Gemm g{(const char*)(ws + OFF_Y2), nullptr, (const char*)(ws + W_HYOUT), 1024, 1024, 1024, 128, 4, 1 << 30, 0, 0};
            EpiRes<5, true, true> E{p.out, p.out, mod1 + 2 * 1024, p.in[I_HBO], (bf16_t*)(ws + OFF_U), p.in[I_NORMG] + 3072, mod1 + 4 * 1024, ss + 2 * M}; pg8::gemm_phase(lds, g, E); } break;
        case 17: if (PH_EN(17)) phase_norm(p.out, nullptr, M, p.in[I_NORMG] + 3072, mod1, 3, 4, (bf16_t*)(ws + OFF_U), nullptr); break;
        case 18: if (PH_EN(18)) { pg8::Gemm g{(const char*)(ws + OFF_U), nullptr, (const char*)(ws + W_M1_1), 1024, 1024, 1024, 128, 16, 1 << 30, 0, 0};
            EpiBf16 E{(bf16_t*)(ws + OFF_H), 4096, nullptr, 1, ss + 2 * M, shw + 4 * 4096 + 4 * 3072}; pg8::gemm_phase(lds, g, E); } break;
        case 19: if (PH_EN(19)) { pg8::Gemm g{(const char*)(ws + OFF_H), nullptr, (const char*)(ws + W_M2_1), 4096, 4096, 4096, 128, 4, 1 << 30, 0, 0};
            EpiRes<7, true, true> E{p.out, ws + OFF_XF, mod1 + 5 * 1024, nullptr, nullptr, nullptr, nullptr, nullptr}; pg8::gemm_phase(lds, g, E); } break;
        case 20: if (PH_EN(20)) phase_final_norm((const bf16_t*)(ws + OFF_XF), p.out, p.in[I_FG]); break;
        case 21: phase_sum_partials((const float*)(ws + OFF_MODP), (float*)(ws + OFF_MOD), 61440); break;
        }
    }
}

extern "C" void kernel_launch(void* const* d_in, const int* in_sizes, int n_in, void* d_out, int out_size, void* d_ws, size_t ws_size, hipStream_t stream) {
    static int grid = 0;
    if (grid == 0) {
        if (n_in != 36 || out_size != M * D || ws_size < WS_NEED) { fprintf(stderr, "kernel_launch: unexpected shapes n_in %d out %d ws %zu\n", n_in, out_size, ws_size); grid = -1; return; }
        int dev = 0, cus = 0, per_cu = 0;
        hipGetDevice(&dev); hipDeviceGetAttribute(&cus, hipDeviceAttributeMultiprocessorCount, dev);
        if (hipFuncSetAttribute((const void*)mega, hipFuncAttributeMaxDynamicSharedMemorySize, LDS_BYTES) != hipSuccess) { fprintf(stderr, "kernel_launch: hipFuncSetAttribute failed\n"); grid = -1; return; }
        if (hipOccupancyMaxActiveBlocksPerMultiprocessor(&per_cu, (const void*)mega, NT, LDS_BYTES) != hipSuccess || per_cu < 1) { fprintf(stderr, "kernel_launch: occupancy query gave %d\n", per_cu); per_cu = 1; }
        (void)hipGetLastError();
        grid = cus * 1;
    }
    if (grid < 0) return;
    hipMemsetAsync((char*)d_ws + OFF_BAR, 0, 16 * 1024, stream);
    hipMemsetAsync((char*)d_ws + OFF_SSI, 0, (size_t)3 * 32768 * 8, stream);
    Params p{};
    for (int i = 0; i < 36; ++i) p.in[i] = (const float*)d_in[i];
    p.out = (float*)d_out; p.ws = (unsigned char*)d_ws;
#ifndef MK_LAUNCHES_PER_PHASE
    p.ph_lo = 0; p.ph_hi = N_PHASES;
    void* args[] = {&p};
    hipError_t e = hipLaunchCooperativeKernel((const void*)mega, dim3(grid), dim3(NT), args, LDS_BYTES, stream);
    if (e != hipSuccess) fprintf(stderr, "cooperative launch failed: %s (grid %d)\n", hipGetErrorString(e), grid);
#else
    for (int ph = 0; ph < N_PHASES; ++ph) {
        p.ph_lo = ph; p.ph_hi = ph + 1;
        void* args[] = {&p};
        hipError_t e = hipLaunchCooperativeKernel((const void*)mega, dim3(grid), dim3(NT), args, LDS_BYTES, stream);
        if (e != hipSuccess) fprintf(stderr, "launch %d failed: %s (grid %d)\n", ph, hipGetErrorString(e), grid);
    }
#endif
}
```

```cpp
#include <hip/hip_runtime.h>
#include <hip/hip_cooperative_groups.h>
#include <cstdio>
#include <cstdint>
namespace cg = cooperative_groups;

#define HD __device__ __forceinline__
#define LAS __attribute__((address_space(3)))
typedef unsigned short bf16_t;
typedef short bf16x8 __attribute__((ext_vector_type(8)));
typedef float f32x4 __attribute__((ext_vector_type(4)));
typedef float f32x2 __attribute__((ext_vector_type(2)));
typedef unsigned u32x4 __attribute__((ext_vector_type(4)));
typedef unsigned u32x2 __attribute__((ext_vector_type(2)));

HD unsigned cvt_pk_bf16(float lo, float hi) { unsigned r; asm volatile("v_cvt_pk_bf16_f32 %0, %1, %2" : "=v"(r) : "v"(lo), "v"(hi)); return r; }
HD float bf_lo(unsigned u) { return __uint_as_float(u << 16); }
HD float bf_hi(unsigned u) { return __uint_as_float(u & 0xffff0000u); }
HD float bf2f(bf16_t b) { return __uint_as_float(((unsigned)b) << 16); }
HD bf16_t f2bf(float f) { return (bf16_t)(cvt_pk_bf16(f, 0.f) & 0xffffu); }
HD int ltid() { int t = threadIdx.x; asm volatile("" : "+v"(t)); return t; }
HD float shfl_xor_f(float v, int mask) { const int lane = ltid() & 63; return __int_as_float(__builtin_amdgcn_ds_bpermute((lane ^ mask) << 2, __float_as_int(v))); }
HD float fsigmoid(float x) { return __frcp_rn(1.0f + __expf(-x)); }

#define XB_TMO      128
#define XB_XCNT(j)  (256  + 64 * (j))
#define XB_XSUB(j)  (1280 + 64 * (j))
#define XB_XGEN(j)  (2304 + 64 * (j))
#define XB_TOP      3328
#define XB_TOPGEN   3392
#define XCD_BAR_WORDS 3456
#define XB_SPIN_CAP (1u << 18)

__device__ __forceinline__ unsigned xb_ld(unsigned* p)              { return __hip_atomic_load(p, __ATOMIC_RELAXED, __HIP_MEMORY_SCOPE_AGENT); }
__device__ __forceinline__ unsigned xb_add(unsigned* p, unsigned v) { return __hip_atomic_fetch_add(p, v, __ATOMIC_RELAXED, __HIP_MEMORY_SCOPE_AGENT); }
__device__ __forceinline__ unsigned xb_xcc_id() { return (unsigned)__builtin_amdgcn_s_getreg((3 << 11) | 20) & 0xFu; }
#define XB_SPIN(cond, bar) do { unsigned _sp = 0; while (cond) { __builtin_amdgcn_s_sleep(1); \
    if ((++_sp & 255u) == 0u) { if (xb_ld(&(bar)[XB_TMO])) break; if (_sp > XB_SPIN_CAP) { atomicAdd(&(bar)[XB_TMO], 1u); break; } } } } while (0)

struct XcdBarrier {
    unsigned* bar; unsigned x;
    volatile LAS unsigned* st;
};

__device__ __forceinline__ XcdBarrier xcd_barrier_post(unsigned* bar, volatile LAS unsigned* st) {
    XcdBarrier b; b.bar = bar; b.x = xb_xcc_id(); b.st = st;
    if (threadIdx.x == 0) (void)xb_add(&bar[XB_XCNT(b.x)], 1u);
    return b;
}
__device__ __forceinline__ void xcd_barrier_complete(unsigned* bar, unsigned x, unsigned& nloc, unsigned& nx) {
    const unsigned G = gridDim.x * gridDim.y * gridDim.z;
    unsigned sum, cnt, mine, sp = 0u;
    for (;;) {
        sum = 0u; cnt = 0u; mine = 0u;
#pragma unroll
        for (unsigned j = 0; j < 16; ++j) { const unsigned c = xb_ld(&bar[XB_XCNT(j)]); sum += c; cnt += (c > 0u) ? 1u : 0u; mine = (j == x) ? c : mine; }
        if (sum == G) break;
        __builtin_amdgcn_s_sleep(1);
        if ((++sp & 255u) == 0u) { if (xb_ld(&bar[XB_TMO])) break; if (sp > XB_SPIN_CAP) { atomicAdd(&bar[XB_TMO], 1u); break; } }
    }
    nloc = mine > 0u ? mine : 1u; nx = cnt > 0u ? cnt : 1u;
}

__device__ __forceinline__ void xcd_barrier(const XcdBarrier& b) {
    asm volatile("s_waitcnt vmcnt(0)" ::: "memory");
    __syncthreads();
    if (threadIdx.x == 0) {
        unsigned* bar = b.bar;
        __builtin_amdgcn_s_waitcnt(0);
        unsigned nloc = b.st[0], nx = b.st[1];
        if (nloc == 0u) { xcd_barrier_complete(bar, b.x, nloc, nx); b.st[0] = nloc; b.st[1] = nx; }
        const unsigned old = xb_add(&bar[XB_XSUB(b.x)], 1u);
        const unsigned gen = old / nloc;
        if (old + 1u == (gen + 1u) * nloc) {
            __builtin_amdgcn_fence(__ATOMIC_RELEASE, "agent");
            asm volatile("s_waitcnt vmcnt(0)" ::: "memory");
            const unsigned og = xb_add(&bar[XB_TOP], 1u);
            const unsigned tg = og / nx;
            if (og + 1u == (tg + 1u) * nx) xb_add(&bar[XB_TOPGEN], 1u);
            else XB_SPIN(xb_ld(&bar[XB_TOPGEN]) == tg, bar);
            __builtin_amdgcn_fence(__ATOMIC_ACQUIRE, "agent");
            xb_add(&bar[XB_XGEN(b.x)], 1u);
            asm volatile("s_waitcnt vmcnt(0)" ::: "memory");
        } else {
            XB_SPIN(xb_ld(&bar[XB_XGEN(b.x)]) == gen, bar);
            __builtin_amdgcn_fence(__ATOMIC_ACQUIRE, "agent");
            asm volatile("s_waitcnt vmcnt(0)" ::: "memory");
        }
    }
    __syncthreads();
}


namespace pg8 {
constexpr int BM = 256, BK = 64, HALF = 128, HTB = HALF * BK * 2, STAGE_BYTES = 8 * HTB, NXCD = 8, WGM = 8;
HD int lds_byte(int r, int c) { const int st = (r >> 4) * 2 + (c >> 5), rr = r & 15, cc = c & 31, ob = rr * 64 + cc * 2; return st * 1024 + (ob ^ (((ob >> 9) & 1) << 5)); }
HD void stage_rc(int b, int& R, int& C) { const int st = b / 1024, sb = b % 1024, swz = sb ^ (((sb >> 9) & 1) << 5); R = (st >> 1) * 16 + swz / 64; C = (st & 1) * 32 + (swz % 64) / 2; }
HD int perm32(int rho) { const int n = rho >> 4, i = rho & 15; return 8 * (i >> 2) + 4 * n + (i & 3); }
struct Unit { int pm, pn; };
struct Gemm { const char* A; const char* A2; const char* Bt; int lda, ldb, K, nM, nN, pm_split, apn_shift, apn_bytes; };
struct StaticOrder {
    int nM, nN, nwg, G, c;
    HD void init(int nM_, int nN_, int G_, int c_) { nM = nM_; nN = nN_; nwg = nM * nN; G = G_; c = c_; }
    HD bool next(int i, Unit& u) const {
        const long L = (long)i * G + c; if (L >= nwg) return false;
        int wgid = (int)L; { const int q = nwg / NXCD, r = nwg % NXCD, xcd = wgid % NXCD, off = wgid / NXCD; wgid = (xcd < r ? xcd * (q + 1) : r * (q + 1) + (xcd - r) * q) + off; }
        const int nig = WGM * nN, gid = wgid / nig, fm = gid * WGM, gsz = (nM - fm) < WGM ? (nM - fm) : WGM;
        u.pm = fm + ((wgid % nig) % gsz); u.pn = (wgid % nig) / gsz; return true;
    }
};

template <class Epi>
HD void gemm_phase(LAS unsigned char* lds, const Gemm g, const Epi& E) {
    const int tid = ltid(), wid = __builtin_amdgcn_readfirstlane(tid >> 6), lane = tid & 63, wr = wid >> 2, wc = wid & 3, fr = lane & 15, fq = lane >> 4;
    StaticOrder S; S.init(g.nM, g.nN, (int)gridDim.x, (int)blockIdx.x);
    const int K = g.K, nt = K / BK;
    unsigned voffA[2], voffB[2];
#pragma unroll
    for (int i = 0; i < 2; ++i) { int R, C; stage_rc(tid * 16 + i * 8192, R, C); const int Rb = Epi::PERM ? ((R & ~31) + perm32(R & 31)) : R;
        voffA[i] = (unsigned)(R * g.lda + C) * 2u; voffB[i] = (unsigned)(Rb * g.ldb + C) * 2u; }
    const size_t kstep = (size_t)(BK * 2);
    const size_t hstepA = (size_t)HALF * g.lda * 2, hstepB = (size_t)HALF * g.ldb * 2;
    const size_t tstepA = 2 * hstepA, tstepB = 2 * hstepB;
    const unsigned ldsw = (unsigned)wid * 1024u;
    const int aoff = lds_byte(wr * 64 + fr, fq * 8), boff = lds_byte(wc * 32 + fr, fq * 8);
#define PG8_APTR(u) ((((u).pm < g.pm_split) ? g.A + (size_t)(u).pm * tstepA : g.A2 + (size_t)((u).pm - g.pm_split) * tstepA) + (size_t)(((u).pn >> g.apn_shift) * g.apn_bytes))
#define PG8_BPTR(u) (g.Bt + (size_t)(u).pn * tstepB)
#define PG8_SA(b, h) (((b) * 2 + (h)) * HTB)
#define PG8_SB(b, h) ((4 + (b) * 2 + (h)) * HTB)
#define PG8_STAGE(bufoff, gbase, voff) do { _Pragma("unroll") for (int _i = 0; _i < 2; ++_i) \
        __builtin_amdgcn_global_load_lds((const unsigned*)((const char*)(gbase) + (voff)[_i]), (LAS unsigned*)(lds + (bufoff) + ldsw + _i * 8192), 16, 0, 0); } while (0)
#define PG8_LDA(dst, b, h) do { _Pragma("unroll") for (int m = 0; m < 4; ++m) _Pragma("unroll") for (int k = 0; k < 2; ++k) dst[m][k] = *(const LAS bf16x8*)(lds + PG8_SA(b, h) + aoff + m * 2048 + k * 1024); } while (0)
#define PG8_LDB(dst, b, h) do { _Pragma("unroll") for (int n = 0; n < 2; ++n) _Pragma("unroll") for (int k = 0; k < 2; ++k) dst[n][k] = *(const LAS bf16x8*)(lds + PG8_SB(b, h) + boff + n * 2048 + k * 1024); } while (0)
#define PG8_MMA(ai, bj, At, Bt) do { __builtin_amdgcn_s_setprio(1); _Pragma("unroll") for (int m = 0; m < 4; ++m) _Pragma("unroll") for (int n = 0; n < 2; ++n) _Pragma("unroll") for (int k = 0; k < 2; ++k) \
        acc[ai][bj][m][n] = __builtin_amdgcn_mfma_f32_16x16x32_bf16(Bt[n][k], At[m][k], acc[ai][bj][m][n], 0, 0, 0); __builtin_amdgcn_s_setprio(0); } while (0)
#define PG8_WAIT_V(n) asm volatile("s_waitcnt vmcnt(" #n ")" ::: "memory")
#define PG8_WAIT_L(n) asm volatile("s_waitcnt lgkmcnt(" #n ")" ::: "memory")
#define PG8_BAR __builtin_amdgcn_s_barrier()
#define PG8_SCHED __builtin_amdgcn_sched_barrier(0)
    Unit cur, nxt; int ui = 0;
    if (!S.next(0, cur)) return;
    f32x4 acc[2][2][4][2];
#pragma unroll
    for (int a = 0; a < 2; ++a)
#pragma unroll
        for (int b = 0; b < 2; ++b)
#pragma unroll
            for (int m = 0; m < 4; ++m)
#pragma unroll
                for (int n = 0; n < 2; ++n) acc[a][b][m][n] = (f32x4){0.f, 0.f, 0.f, 0.f};
    bf16x8 At[4][2], B0[2][2], B1[2][2];
    const char* cA = PG8_APTR(cur); const char* cB = PG8_BPTR(cur);
    PG8_STAGE(PG8_SB(0, 0), cB, voffB); PG8_STAGE(PG8_SA(0, 0), cA, voffA); PG8_STAGE(PG8_SB(0, 1), cB + hstepB, voffB); PG8_STAGE(PG8_SA(0, 1), cA + hstepA, voffA);
    if (wr == 1) PG8_BAR;
    PG8_WAIT_V(4); PG8_BAR;
    PG8_STAGE(PG8_SB(1, 0), cB + kstep, voffB); PG8_STAGE(PG8_SA(1, 0), cA + kstep, voffA); PG8_STAGE(PG8_SB(1, 1), cB + hstepB + kstep, voffB);
    PG8_WAIT_V(6); PG8_BAR;
    for (;;) {
        const bool has_next = S.next(ui + 1, nxt);
        const char* nA = has_next ? PG8_APTR(nxt) : cA; const char* nB = has_next ? PG8_BPTR(nxt) : cB;
#pragma unroll 1
        for (int t = 0; t < nt; t += 2) {
            const bool last = (t == nt - 2);
            const char* a1 = cA + (size_t)(t + 1) * kstep;
            const char* a2 = last ? nA : cA + (size_t)(t + 2) * kstep; const char* b2 = last ? nB : cB + (size_t)(t + 2) * kstep;
            const char* a3 = a2 + kstep; const char* b3 = b2 + kstep;
            PG8_LDB(B0, 0, 0); PG8_SCHED; PG8_LDA(At, 0, 0); PG8_STAGE(PG8_SA(1, 1), a1 + hstepA, voffA);
            PG8_WAIT_L(8); PG8_BAR; PG8_WAIT_L(0); PG8_MMA(0, 0, At, B0); PG8_BAR; PG8_SCHED;
            PG8_LDB(B1, 0, 1); PG8_STAGE(PG8_SB(0, 0), b2, voffB);
            PG8_BAR; PG8_WAIT_L(0); PG8_MMA(0, 1, At, B1); PG8_BAR;
            PG8_LDA(At, 0, 1); PG8_STAGE(PG8_SA(0, 0), a2, voffA);
            PG8_BAR; PG8_WAIT_L(0); PG8_MMA(1, 0, At, B0); PG8_BAR; PG8_SCHED;
            PG8_STAGE(PG8_SB(0, 1), b2 + hstepB, voffB);
            PG8_WAIT_V(6); PG8_BAR; PG8_MMA(1, 1, At, B1); PG8_BAR;
            PG8_LDB(B0, 1, 0); PG8_SCHED; PG8_LDA(At, 1, 0); PG8_STAGE(PG8_SA(0, 1), a2 + hstepA, voffA);
            PG8_WAIT_L(8); PG8_BAR; PG8_WAIT_L(0); PG8_MMA(0, 0, At, B0); PG8_BAR; PG8_SCHED;
            PG8_LDB(B1, 1, 1); PG8_STAGE(PG8_SB(1, 0), b3, voffB);
            PG8_BAR; PG8_WAIT_L(0); PG8_MMA(0, 1, At, B1); PG8_BAR;
            PG8_LDA(At, 1, 1); PG8_STAGE(PG8_SA(1, 0), a3, voffA);
            PG8_BAR; PG8_WAIT_L(0); PG8_MMA(1, 0, At, B0); PG8_BAR; PG8_SCHED;
            PG8_STAGE(PG8_SB(1, 1), b3 + hstepB, voffB);
            PG8_WAIT_V(6); PG8_BAR; PG8_MMA(1, 1, At, B1); PG8_BAR;
        }
        E(acc, cur, wr, wc, fr, fq);
        if (!has_next) break;
#pragma unroll
        for (int a = 0; a < 2; ++a)
#pragma unroll
            for (int b = 0; b < 2; ++b)
#pragma unroll
                for (int m = 0; m < 4; ++m)
#pragma unroll
                    for (int n = 0; n < 2; ++n) acc[a][b][m][n] = (f32x4){0.f, 0.f, 0.f, 0.f};
        cur = nxt; cA = nA; cB = nB; ++ui;
    }
    PG8_WAIT_V(0);
    if (wr == 0) PG8_BAR;
    PG8_BAR;
#undef PG8_APTR
#undef PG8_BPTR
#undef PG8_SA
#undef PG8_SB
#undef PG8_STAGE
#undef PG8_LDA
#undef PG8_LDB
#undef PG8_MMA
#undef PG8_WAIT_V
#undef PG8_WAIT_L
#undef PG8_BAR
#undef PG8_SCHED
}
}
using pg8::Unit;
#ifndef HD
#define HD __device__ __forceinline__
#endif
#if defined(__HIP_DEVICE_COMPILE__)
#define OPAQUE(x) asm volatile("" : "+v"(x))
#else
#define OPAQUE(x)
#endif
#if defined(__HIP_DEVICE_COMPILE__)
#define LDSQ __attribute__((address_space(3)))
#else
#define LDSQ
#endif
#if defined(__HIP_DEVICE_COMPILE__)
#define FFT_SCHED_FENCE() __builtin_amdgcn_sched_barrier(0)
#else
#define FFT_SCHED_FENCE()
#endif
typedef float v2 __attribute__((ext_vector_type(2)));
struct c2 { v2 re, im; };
HD c2 c2add(c2 a, c2 b) { return c2{a.re + b.re, a.im + b.im}; }
HD c2 c2sub(c2 a, c2 b) { return c2{a.re - b.re, a.im - b.im}; }
HD c2 c2mul(c2 a, c2 b) { return c2{a.re * b.re - a.im * b.im, a.re * b.im + a.im * b.re}; }
HD c2 c2mulc(c2 a, c2 b) { return c2{a.re * b.re + a.im * b.im, a.im * b.re - a.re * b.im}; }
HD int PIX(int i) { return i + ((i >> 6) << 2); }
#define FFT_PLANE 17408
#define BREV4(j) ((((j) & 1) << 3) | (((j) & 2) << 1) | (((j) & 4) >> 1) | (((j) & 8) >> 3))

template <int K, bool CONJ> HD c2 mulw16(c2 a) {
    constexpr float C[8] = {1.f, 0.92387953251128674f, 0.70710678118654752f, 0.38268343236508977f, 0.f, -0.38268343236508977f, -0.70710678118654752f, -0.92387953251128674f};
    constexpr float S[8] = {0.f, -0.38268343236508977f, -0.70710678118654752f, -0.92387953251128674f, -1.f, -0.92387953251128674f, -0.70710678118654752f, -0.38268343236508977f};
    if (K == 0) return a;
    if (K == 4) return CONJ ? c2{-a.im, a.re} : c2{a.im, -a.re};
    const float c = C[K], s = CONJ ? -S[K] : S[K];
    return c2{a.re * c - a.im * s, a.re * s + a.im * c};
}
HD void dft16_fwd(c2 (&e)[16]) {
#define BF_F(i0, i1, K) { const c2 a = e[i0], b = e[i1]; e[i0] = c2add(a, b); e[i1] = mulw16<K, false>(c2sub(a, b)); }
    BF_F(0, 8, 0) BF_F(1, 9, 1) BF_F(2, 10, 2) BF_F(3, 11, 3) BF_F(4, 12, 4) BF_F(5, 13, 5) BF_F(6, 14, 6) BF_F(7, 15, 7)
    BF_F(0, 4, 0) BF_F(1, 5, 2) BF_F(2, 6, 4) BF_F(3, 7, 6) BF_F(8, 12, 0) BF_F(9, 13, 2) BF_F(10, 14, 4) BF_F(11, 15, 6)
    BF_F(0, 2, 0) BF_F(1, 3, 4) BF_F(4, 6, 0) BF_F(5, 7, 4) BF_F(8, 10, 0) BF_F(9, 11, 4) BF_F(12, 14, 0) BF_F(13, 15, 4)
    BF_F(0, 1, 0) BF_F(2, 3, 0) BF_F(4, 5, 0) BF_F(6, 7, 0) BF_F(8, 9, 0) BF_F(10, 11, 0) BF_F(12, 13, 0) BF_F(14, 15, 0)
#undef BF_F
}
HD void dft16_inv(c2 (&e)[16]) {
#define BF_I(i0, i1, K) { const c2 a = e[i0], b = mulw16<K, true>(e[i1]); e[i0] = c2add(a, b); e[i1] = c2sub(a, b); }
    BF_I(0, 1, 0) BF_I(2, 3, 0) BF_I(4, 5, 0) BF_I(6, 7, 0) BF_I(8, 9, 0) BF_I(10, 11, 0) BF_I(12, 13, 0) BF_I(14, 15, 0)
    BF_I(0, 2, 0) BF_I(1, 3, 4) BF_I(4, 6, 0) BF_I(5, 7, 4) BF_I(8, 10, 0) BF_I(9, 11, 4) BF_I(12, 14, 0) BF_I(13, 15, 4)
    BF_I(0, 4, 0) BF_I(1, 5, 2) BF_I(2, 6, 4) BF_I(3, 7, 6) BF_I(8, 12, 0) BF_I(9, 13, 2) BF_I(10, 14, 4) BF_I(11, 15, 6)
    BF_I(0, 8, 0) BF_I(1, 9, 1) BF_I(2, 10, 2) BF_I(3, 11, 3) BF_I(4, 12, 4) BF_I(5, 13, 5) BF_I(6, 14, 6) BF_I(7, 15, 7)
#undef BF_I
}
HD void fft_sincos_rev(float rev, float& s, float& c) {
#if defined(__HIP_DEVICE_COMPILE__)
    s = __builtin_amdgcn_sinf(rev); c = __builtin_amdgcn_cosf(rev);
#else
    s = sinf(6.283185307179586f * rev); c = cosf(6.283185307179586f * rev);
#endif
}
template <int Q, bool INV, bool HALF>
HD void fft_pass16(float* re, float* im, int tid) {
    OPAQUE(tid);
    constexpr int QP = (Q >= 64) ? Q + (Q >> 6) * 4 : Q;
    const int low = 2 * (tid & (Q / 2 - 1)), grp = tid / (Q / 2), pb = PIX(grp * 16 * Q + low), pg = grp * 68;
    float* const rb = re + pb; float* const ib = im + pb;
    c2 tw[16];
    { float sa, ca, sb, cb; fft_sincos_rev((float)low * (1.0f / (16.0f * Q)), sa, ca); fft_sincos_rev((float)(low + 1) * (1.0f / (16.0f * Q)), sb, cb);
      tw[1] = c2{v2{ca, cb}, v2{-sa, -sb}}; }
    tw[2] = c2mul(tw[1], tw[1]); tw[3] = c2mul(tw[2], tw[1]); tw[4] = c2mul(tw[2], tw[2]);
    tw[5] = c2mul(tw[4], tw[1]); tw[6] = c2mul(tw[4], tw[2]); tw[7] = c2mul(tw[4], tw[3]); tw[8] = c2mul(tw[4], tw[4]);
#pragma unroll
    for (int k = 9; k < 16; ++k) tw[k] = c2mul(tw[8], tw[k - 8]);
    c2 e[16];
    if (!INV) {
#pragma unroll
        for (int m = 0; m < 16; ++m) {
            if (HALF && m >= 8) e[m] = c2{v2{0.f, 0.f}, v2{0.f, 0.f}};
            else { e[m].re = *(const v2*)(rb + m * QP); e[m].im = *(const v2*)(ib + m * QP); }
        }
        dft16_fwd(e);
        if (Q == 4) {
#pragma unroll
            for (int q = 0; q < 8; ++q) {
                const int k0 = 2 * q, k1 = 2 * q + 1;
                const c2 o0 = (k0 == 0) ? e[BREV4(k0)] : c2mul(e[BREV4(k0)], tw[k0]), o1 = c2mul(e[BREV4(k1)], tw[k1]);
                const int pos = pg + q * 8 + low;
                *(v2*)(re + pos) = v2{o0.re.x, o1.re.x}; *(v2*)(re + pos + 4) = v2{o0.re.y, o1.re.y};
                *(v2*)(im + pos) = v2{o0.im.x, o1.im.x}; *(v2*)(im + pos + 4) = v2{o0.im.y, o1.im.y};

            }
        } else {
#pragma unroll
            for (int j = 0; j < 16; ++j) { const int k = BREV4(j); const c2 o = (k == 0) ? e[j] : c2mul(e[j], tw[k]); *(v2*)(rb + k * QP) = o.re; *(v2*)(ib + k * QP) = o.im; }
        }
    } else {
        if (Q == 4) {
#pragma unroll
            for (int q = 0; q < 8; ++q) {
                const int k0 = 2 * q, k1 = 2 * q + 1, pos = pg + q * 8 + low;
                const v2 ra = *(const v2*)(re + pos), rb2 = *(const v2*)(re + pos + 4), ia = *(const v2*)(im + pos), ib2 = *(const v2*)(im + pos + 4);
                const c2 v0{v2{ra.x, rb2.x}, v2{ia.x, ib2.x}}, v1{v2{ra.y, rb2.y}, v2{ia.y, ib2.y}};
                e[BREV4(k0)] = (k0 == 0) ? v0 : c2mulc(v0, tw[k0]); e[BREV4(k1)] = c2mulc(v1, tw[k1]);
                if (q == 3) FFT_SCHED_FENCE();

            }
        } else {
#pragma unroll
            for (int j = 0; j < 16; ++j) { const int k = BREV4(j); c2 v; v.re = *(const v2*)(rb + k * QP); v.im = *(const v2*)(ib + k * QP); e[j] = (k == 0) ? v : c2mulc(v, tw[k]); }
        }
        dft16_inv(e);
#pragma unroll
        for (int m = 0; m < 16; ++m) if (!(HALF && m >= 8)) { *(v2*)(rb + m * QP) = e[m].re; *(v2*)(ib + m * QP) = e[m].im; }
    }
}
HD void dft4_fwd(c2& a, c2& b, c2& c, c2& d) {
    const c2 s0 = c2add(a, c), s1 = c2sub(a, c), s2 = c2add(b, d), s3 = c2sub(b, d);
    a = c2add(s0, s2); c = c2sub(s0, s2);
    b = c2{s1.re + s3.im, s1.im - s3.re};
    d = c2{s1.re - s3.im, s1.im + s3.re};
}
HD void dft4_inv(c2& a, c2& b, c2& c, c2& d) {
    const c2 s0 = c2add(a, c), s1 = c2sub(a, c), s2 = c2add(b, d), s3 = c2sub(b, d);
    a = c2add(s0, s2); c = c2sub(s0, s2);
    b = c2{s1.re - s3.im, s1.im + s3.re};
    d = c2{s1.re + s3.im, s1.im - s3.re};
}
typedef float v4 __attribute__((ext_vector_type(4)));
template <int MODE>
HD void fft_r4(float* re, float* im, float* spre, float* spim, float scale, int tid) {
    OPAQUE(tid);
#pragma unroll
    for (int it = 0; it < 4; ++it) {
        const int j = tid + 512 * it;
        const int off = (j >> 3) * 68 + (j & 7) * 8;
        const v4 r0 = *(const v4*)(re + off), r1 = *(const v4*)(re + off + 4), i0 = *(const v4*)(im + off), i1 = *(const v4*)(im + off + 4);
        c2 a{v2{r0.x, r0.y}, v2{i0.x, i0.y}}, c{v2{r0.z, r0.w}, v2{i0.z, i0.w}}, b{v2{r1.x, r1.y}, v2{i1.x, i1.y}}, d{v2{r1.z, r1.w}, v2{i1.z, i1.w}};
        dft4_fwd(a, b, c, d);
        if (MODE == 0) {
            *(v4*)(spre + j * 8) = v4{a.re.x, a.re.y, c.re.x, c.re.y} * scale; *(v4*)(spre + j * 8 + 4) = v4{b.re.x, b.re.y, d.re.x, d.re.y} * scale;
            *(v4*)(spim + j * 8) = v4{a.im.x, a.im.y, c.im.x, c.im.y} * scale; *(v4*)(spim + j * 8 + 4) = v4{b.im.x, b.im.y, d.im.x, d.im.y} * scale;
        } else {
            const v4 kr0 = *(const v4*)(spre + j * 8), kr1 = *(const v4*)(spre + j * 8 + 4), ki0 = *(const v4*)(spim + j * 8), ki1 = *(const v4*)(spim + j * 8 + 4);
            a = c2mul(a, c2{v2{kr0.x, kr0.y}, v2{ki0.x, ki0.y}}); c = c2mul(c, c2{v2{kr0.z, kr0.w}, v2{ki0.z, ki0.w}});
            b = c2mul(b, c2{v2{kr1.x, kr1.y}, v2{ki1.x, ki1.y}}); d = c2mul(d, c2{v2{kr1.z, kr1.w}, v2{ki1.z, ki1.w}});
            dft4_inv(a, b, c, d);
            *(v4*)(re + off) = v4{a.re.x, a.re.y, c.re.x, c.re.y}; *(v4*)(re + off + 4) = v4{b.re.x, b.re.y, d.re.x, d.re.y};
            *(v4*)(im + off) = v4{a.im.x, a.im.y, c.im.x, c.im.y}; *(v4*)(im + off + 4) = v4{b.im.x, b.im.y, d.im.x, d.im.y};
        }
    }
}
HD int fft_slot_of_freq(int f) { const int k1 = f & 15, k2 = (f >> 4) & 15, k3 = (f >> 8) & 15, k4 = f >> 12; return (16 * k1 + k2) * 64 + (k3 >> 1) * 8 + 4 * (k4 & 1) + 2 * (k4 >> 1) + (k3 & 1); }
HD int fft_freq_of_slot(int s) { const int b = s >> 6, k1 = b >> 4, k2 = b & 15, w = s & 7, k3 = 2 * ((s >> 3) & 7) + (w & 1), k4 = ((w >> 2) & 1) + 2 * ((w >> 1) & 1); return k1 + 16 * k2 + 256 * k3 + 4096 * k4; }
HD void fft_hermitian_unpack(const float* re, const float* im, float* sp0, float* sp1, float scale, int tid) {
    OPAQUE(tid);
    const float h = 0.5f * scale;
#pragma unroll 4
    for (int it = 0; it < 32; ++it) {
        const int s = tid + 512 * it, f = fft_freq_of_slot(s), s2 = fft_slot_of_freq((16384 - f) & 16383);
        const int p = (s >> 6) * 68 + (s & 63), p2 = (s2 >> 6) * 68 + (s2 & 63);
        const float zr = re[p], zi = im[p], wr = re[p2], wi = im[p2];
        sp0[s] = (zr + wr) * h; sp0[16384 + s] = (zi - wi) * h;
        sp1[s] = (zi + wi) * h; sp1[16384 + s] = (wr - zr) * h;
    }
}
HD void fft_r4_fwd_inplace(float* re, float* im, int tid) {
    OPAQUE(tid);
#pragma unroll
    for (int it = 0; it < 4; ++it) {
        const int j = tid + 512 * it;
        const int off = (j >> 3) * 68 + (j & 7) * 8;
        const v4 r0 = *(const v4*)(re + off), r1 = *(const v4*)(re + off + 4), i0 = *(const v4*)(im + off), i1 = *(const v4*)(im + off + 4);
        c2 a{v2{r0.x, r0.y}, v2{i0.x, i0.y}}, c{v2{r0.z, r0.w}, v2{i0.z, i0.w}}, b{v2{r1.x, r1.y}, v2{i1.x, i1.y}}, d{v2{r1.z, r1.w}, v2{i1.z, i1.w}};
        dft4_fwd(a, b, c, d);
        *(v4*)(re + off) = v4{a.re.x, a.re.y, c.re.x, c.re.y}; *(v4*)(re + off + 4) = v4{b.re.x, b.re.y, d.re.x, d.re.y};
        *(v4*)(im + off) = v4{a.im.x, a.im.y, c.im.x, c.im.y}; *(v4*)(im + off + 4) = v4{b.im.x, b.im.y, d.im.x, d.im.y};
    }
}
constexpr int D = 1024, NB = 4, SEQ = 8192, M = NB * SEQ, CTXL = 256, MC = NB * CTXL, NT = 512;
constexpr size_t MiB = 1ull << 20;
constexpr size_t OFF_MOD = 0;
constexpr size_t OFF_BAR = 240 * 1024;
constexpr size_t OFF_SS = 256 * 1024;
constexpr size_t OFF_SHW = 14 * MiB + 512 * 1024;
constexpr size_t MOD_BYTES = 832 * 1024;
constexpr size_t OFF_SP = 15 * MiB;
constexpr size_t OFF_BH3 = 1 * MiB;
constexpr size_t OFF_FW4T = 5 * MiB;
constexpr size_t OFF_SSI = 256 * 1024;
constexpr size_t OFF_MODP = 7 * MiB;
constexpr size_t OFF_SHWP = 472 * MiB;
constexpr size_t OFF_W = 16 * MiB;
constexpr size_t W_IN0 = OFF_W, W_GATE = W_IN0 + 4 * MiB, W_OUT0 = W_GATE + 2 * MiB, W_M1_0 = W_OUT0 + 2 * MiB, W_M2_0 = W_M1_0 + 8 * MiB,
                 W_HYIN = W_M2_0 + 8 * MiB, W_HYOUT = W_HYIN + 6 * MiB, W_M1_1 = W_HYOUT + 2 * MiB, W_M2_1 = W_M1_1 + 8 * MiB;
constexpr size_t OFF_U = 64 * MiB;
constexpr size_t OFF_HG = 128 * MiB;
constexpr size_t OFF_LA = 192 * MiB;
constexpr size_t OFF_BX = 320 * MiB;
constexpr size_t OFF_UC = 448 * MiB;
constexpr size_t OFF_ZRC = 450 * MiB;
constexpr size_t OFF_LAC = 452 * MiB;
constexpr size_t OFF_BXC = 456 * MiB;
constexpr size_t OFF_SUMA = 460 * MiB;
constexpr size_t OFF_SUMH = 466 * MiB;
constexpr size_t OFF_H = 128 * MiB;
constexpr size_t OFF_XF = 384 * MiB;
constexpr size_t OFF_Z3 = 128 * MiB;
constexpr size_t OFF_T = 320 * MiB;
constexpr size_t OFF_HRAW = 64 * MiB;
constexpr size_t OFF_SPEC = 128 * MiB;
constexpr size_t OFF_Y2 = 192 * MiB;
constexpr size_t WS_NEED = 512 * MiB;
constexpr int LDS_BYTES = 140 * 1024;

struct Params { const float* in[36]; float* out; unsigned char* ws; int ph_lo, ph_hi; };
enum { I_X = 0, I_C, I_CTX, I_CCTX, I_ADAW, I_ADAB, I_NORMG, I_W1, I_W2, I_LWIN, I_LBIN, I_LCW, I_LCB, I_LWA, I_LBA, I_LWI, I_LBI, I_LAM, I_LWO, I_LBO,
       I_HWIN, I_HBIN, I_HCW, I_HCB, I_FW1, I_FB1, I_FW2, I_FB2, I_FW3, I_FB3, I_FW4, I_FREQ, I_SKIP, I_HWO, I_HBO, I_FG };

struct EpiIn0 {
    static constexpr bool PERM = true;
    bf16_t* G; bf16_t* ZR; bf16_t* ZRc; const float* bias;
    HD void operator()(const f32x4 (&acc)[2][2][4][2], const Unit& u, int wr, int wc, int fr, int fq) const {
        const bool isctx = u.pm >= 128, isgate = u.pn < 4;
        if (isctx && isgate) return;
        const int row0 = (isctx ? (u.pm - 128) : u.pm) * 256 + wr * 64 + fr;
        const int colg = u.pn * 256 + wc * 32 + 8 * fq;
        const int colo = isgate ? colg : colg - 1024;
        if (isctx) body<false>(acc, ZRc, row0, colg, colo); else if (isgate) body<true>(acc, G, row0, colg, colo); else body<false>(acc, ZR, row0, colg, colo);
    }
    template <bool isgate> HD void body(const f32x4 (&acc)[2][2][4][2], bf16_t* base, int row0, int colg, int colo) const {
#pragma unroll
        for (int bj = 0; bj < 2; ++bj) {
            const f32x4 b0 = *(const f32x4*)(bias + colg + bj * 128), b1 = *(const f32x4*)(bias + colg + bj * 128 + 4);
#pragma unroll
            for (int ai = 0; ai < 2; ++ai)
#pragma unroll
                for (int m = 0; m < 4; ++m) {
                    f32x4 v0 = acc[ai][bj][m][0] + b0, v1 = acc[ai][bj][m][1] + b1;
                    if (isgate) {
#pragma unroll
                        for (int j = 0; j < 4; ++j) {
                            float x = v0[j]; v0[j] = x * fsigmoid(1.5957691216f * (x + 0.044715f * x * x * x));
                            x = v1[j]; v1[j] = x * fsigmoid(1.5957691216f * (x + 0.044715f * x * x * x));
                        }
                    }
                    u32x4 w; w.x = cvt_pk_bf16(v0[0], v0[1]); w.y = cvt_pk_bf16(v0[2], v0[3]); w.z = cvt_pk_bf16(v1[0], v1[1]); w.w = cvt_pk_bf16(v1[2], v1[3]);
                    *(u32x4*)(base + (size_t)(row0 + ai * 128 + m * 16) * 1024 + colo + bj * 128) = w;
                }
        }
    }
};
struct EpiBf16 {
    static constexpr bool PERM = true;
    bf16_t* O; int ldc; const float* bias; int act; const unsigned long long* ss; const float* shw;
    HD void operator()(const f32x4 (&acc)[2][2][4][2], const Unit& u, int wr, int wc, int fr, int fq) const {
        const int row0 = u.pm * 256 + wr * 64 + fr, col0 = u.pn * 256 + wc * 32 + 8 * fq;
        float rs[2][4]; f32x4 bb[2][2];
#pragma unroll
        for (int ai = 0; ai < 2; ++ai)
#pragma unroll
            for (int m = 0; m < 4; ++m) rs[ai][m] = ss ? (float)ss[row0 + ai * 128 + m * 16] * (1.0f / 65536.0f) : 0.f;
#pragma unroll
        for (int bj = 0; bj < 2; ++bj) {
            bb[bj][0] = (f32x4){0.f, 0.f, 0.f, 0.f}; bb[bj][1] = bb[bj][0];
            if (bias) { bb[bj][0] = *(const f32x4*)(bias + col0 + bj * 128); bb[bj][1] = *(const f32x4*)(bias + col0 + bj * 128 + 4); }
            if (ss) { const float* sw = shw + (size_t)((u.pm * 256) >> 13) * ldc + col0 + bj * 128; bb[bj][0] += *(const f32x4*)sw; bb[bj][1] += *(const f32x4*)(sw + 4); }
        }
#pragma unroll
        for (int ai = 0; ai < 2; ++ai)
#pragma unroll
            for (int m = 0; m < 4; ++m) rs[ai][m] = ss ? rsqrtf(rs[ai][m] * (1.0f / 1024.0f) + 1e-6f) : 1.0f;
#pragma unroll
        for (int bj = 0; bj < 2; ++bj) {
#pragma unroll
            for (int ai = 0; ai < 2; ++ai)
#pragma unroll
                for (int m = 0; m < 4; ++m) {
                    f32x4 v0 = acc[ai][bj][m][0] * rs[ai][m] + bb[bj][0], v1 = acc[ai][bj][m][1] * rs[ai][m] + bb[bj][1];
                    if (act == 1) {
#pragma unroll
                        for (int j = 0; j < 4; ++j) { float x = fmaxf(v0[j], 0.f); v0[j] = x * x; x = fmaxf(v1[j], 0.f); v1[j] = x * x; }
                    }
                    u32x4 w; w.x = cvt_pk_bf16(v0[0], v0[1]); w.y = cvt_pk_bf16(v0[2], v0[3]); w.z = cvt_pk_bf16(v1[0], v1[1]); w.w = cvt_pk_bf16(v1[2], v1[3]);
                    *(u32x4*)(O + (size_t)(row0 + ai * 128 + m * 16) * ldc + col0 + bj * 128) = w;
                }
        }
    }
};
template <int DEPTH, bool XIN_BF, bool XOUT_BF> struct EpiRes {
    static constexpr bool PERM = true;
    const void* xin; void* xout; const float* gate;   const float* bias;
    bf16_t* U; const float* gn; const float* scn; unsigned long long* ss;
    HD void operator()(f32x4 (&acc)[2][2][4][2], const Unit& u, int wr, int wc, int fr, int fq) const {
        const int row0 = u.pm * 256 + wr * 64 + fr, col0 = u.pn * 256 + wc * 32 + 8 * fq;
        const int b = (u.pm * 256) >> 13;
        float sq[2][4];
#pragma unroll
        for (int ai = 0; ai < 2; ++ai)
#pragma unroll
            for (int m = 0; m < 4; ++m) sq[ai][m] = 0.f;
#pragma unroll
        for (int bj = 0; bj < 2; ++bj) {
            const int c = col0 + bj * 128;
            constexpr int NB_ = DEPTH + 1;
            f32x4 xb[XIN_BF ? 1 : NB_][2]; u32x4 xh[XIN_BF ? NB_ : 1];
#define ER_LOAD(s) { const size_t ro_ = (size_t)(row0 + ((s) >> 2) * 128 + ((s) & 3) * 16) * 1024 + c; \
                if (XIN_BF) xh[XIN_BF ? (s) % NB_ : 0] = *(const u32x4*)((const bf16_t*)xin + ro_); \
                else { xb[XIN_BF ? 0 : (s) % NB_][0] = *(const f32x4*)((const float*)xin + ro_); xb[XIN_BF ? 0 : (s) % NB_][1] = *(const f32x4*)((const float*)xin + ro_ + 4); } }
#pragma unroll
            for (int s0 = 0; s0 < DEPTH; ++s0) ER_LOAD(s0)
            f32x4 gs0 = (f32x4){0.f, 0.f, 0.f, 0.f}, gs1 = gs0;
            if (bias) { const f32x4 bv0 = *(const f32x4*)(bias + c), bv1 = *(const f32x4*)(bias + c + 4);
#pragma unroll
                for (int ai = 0; ai < 2; ++ai)
#pragma unroll
                    for (int m = 0; m < 4; ++m) { acc[ai][bj][m][0] += bv0; acc[ai][bj][m][1] += bv1; } }
            const f32x4 gv0 = *(const f32x4*)(gate + b * 6144 + c), gv1 = *(const f32x4*)(gate + b * 6144 + c + 4);
            if (U) { gs0 = *(const f32x4*)(gn + c) * (*(const f32x4*)(scn + b * 6144 + c) + 1.0f); gs1 = *(const f32x4*)(gn + c + 4) * (*(const f32x4*)(scn + b * 6144 + c + 4) + 1.0f); }
#pragma unroll
            for (int s = 0; s < 8; ++s) {
                if (s + DEPTH < 8) ER_LOAD(s + DEPTH)
                {
                    const int ai = s >> 2, m = s & 3;
                    const size_t ro = (size_t)(row0 + ai * 128 + m * 16) * 1024 + c;
                    f32x4 xi0, xi1;
                    if (XIN_BF) { const u32x4 h = xh[XIN_BF ? s % NB_ : 0]; xi0 = (f32x4){bf_lo(h.x), bf_hi(h.x), bf_lo(h.y), bf_hi(h.y)}; xi1 = (f32x4){bf_lo(h.z), bf_hi(h.z), bf_lo(h.w), bf_hi(h.w)}; }
                    else { xi0 = xb[XIN_BF ? 0 : s % NB_][0]; xi1 = xb[XIN_BF ? 0 : s % NB_][1]; }
                    const f32x4 x0 = xi0 + gv0 * acc[ai][bj][m][0], x1 = xi1 + gv1 * acc[ai][bj][m][1];
                    if (XOUT_BF) { u32x4 wx; wx.x = cvt_pk_bf16(x0[0], x0[1]); wx.y = cvt_pk_bf16(x0[2], x0[3]); wx.z = cvt_pk_bf16(x1[0], x1[1]); wx.w = cvt_pk_bf16(x1[2], x1[3]); *(u32x4*)((bf16_t*)xout + ro) = wx; }
                    else { *(f32x4*)((float*)xout + ro) = x0; *(f32x4*)((float*)xout + ro + 4) = x1; }
                    if (U) {
                        sq[ai][m] += (x0[0] * x0[0] + x0[1] * x0[1]) + (x0[2] * x0[2] + x0[3] * x0[3]) + (x1[0] * x1[0] + x1[1] * x1[1]) + (x1[2] * x1[2] + x1[3] * x1[3]);
                        const f32x4 y0 = x0 * gs0, y1 = x1 * gs1;
                        u32x4 w; w.x = cvt_pk_bf16(y0[0], y0[1]); w.y = cvt_pk_bf16(y0[2], y0[3]); w.z = cvt_pk_bf16(y1[0], y1[1]); w.w = cvt_pk_bf16(y1[2], y1[3]);
                        *(u32x4*)(U + ro) = w;
                    }
                }
            }
#undef ER_LOAD
        }
        if (U) {
#pragma unroll
            for (int ai = 0; ai < 2; ++ai)
#pragma unroll
                for (int m = 0; m < 4; ++m) { float s = sq[ai][m]; s += shfl_xor_f(s, 16); s += shfl_xor_f(s, 32); if (fq == 0) atomicAdd(ss + row0 + ai * 128 + m * 16, (unsigned long long)__float2ll_rn(s * 65536.0f)); }
        }
    }
};
struct EpiGates {
    static constexpr bool PERM = false;
    const bf16_t* XL; const bf16_t* XLc; bf16_t* LA; bf16_t* BX; bf16_t* LAc; bf16_t* BXc; const float* b_a; const float* b_i; const float* sp;
    HD void operator()(const f32x4 (&acc)[2][2][4][2], const Unit& u, int wr, int wc, int fr, int fq) const {
        const bool isctx = u.pm >= 128;
        const int head = u.pn >> 2, dir = (u.pn >> 1) & 1, half = u.pn & 1;
        const int row0 = (isctx ? (u.pm - 128) : u.pm) * 256 + wr * 64 + fr;
        if (isctx) body(acc, XLc, LAc + (size_t)dir * MC * 1024, BXc + (size_t)dir * MC * 1024, head, dir, half, row0, wc, fq);
        else body(acc, XL, LA + (size_t)dir * M * 1024, BX + (size_t)dir * M * 1024, head, dir, half, row0, wc, fq);
    }
    HD void body(const f32x4 (&acc)[2][2][4][2], const bf16_t* xb, bf16_t* la, bf16_t* bx, int head, int dir, int half, int row0, int wc, int fq) const {
#pragma unroll
        for (int bj = 0; bj < 2; ++bj) {
            const int chg = head * 256 + half * 128 + bj * 64 + wc * 16 + fq * 4;
            const f32x4 ba = *(const f32x4*)(b_a + dir * 1024 + chg), bi = *(const f32x4*)(b_i + dir * 1024 + chg), spv = *(const f32x4*)(sp + dir * 1024 + chg);
#pragma unroll
            for (int am = 0; am < 4; ++am) {
                u32x2 xrr[2];
#pragma unroll
                for (int r = 0; r < 2; ++r) xrr[r] = *(const u32x2*)(xb + (size_t)(row0 + (am >> 1) * 128 + (2 * (am & 1) + r) * 16) * 1024 + chg);
#pragma unroll
                for (int r = 0; r < 2; ++r) {
                    const int ai = am >> 1, m = 2 * (am & 1) + r;
                    const size_t o = (size_t)(row0 + ai * 128 + m * 16) * 1024 + chg;
                    const u32x2 xr = xrr[r];
                    const float xv[4] = {bf_lo(xr.x), bf_hi(xr.x), bf_lo(xr.y), bf_hi(xr.y)};
                    float lo[4], bo[4];
#pragma unroll
                    for (int j = 0; j < 4; ++j) {
                        const float r = fsigmoid(acc[ai][bj][m][0][j] + ba[j]), ig = fsigmoid(acc[ai][bj][m][1][j] + bi[j]);
                        const float l = -8.0f * r * spv[j], t2 = 2.0f * l;
                        const float om = (t2 > -0.05f) ? -t2 * (1.0f + t2 * (0.5f + t2 * (1.0f / 6.0f))) : 1.0f - __expf(t2);
                        lo[j] = l; bo[j] = __fsqrt_rn(fmaxf(om, 0.f)) * ig * xv[j];
                    }
                    u32x2 w; w.x = cvt_pk_bf16(lo[0], lo[1]); w.y = cvt_pk_bf16(lo[2], lo[3]); *(u32x2*)(la + o) = w;
                    w.x = cvt_pk_bf16(bo[0], bo[1]); w.y = cvt_pk_bf16(bo[2], bo[3]); *(u32x2*)(bx + o) = w;
                }
            }
        }
    }
};

HD float wave_sum(float v) {
#pragma unroll
    for (int o = 32; o >= 1; o >>= 1) v += shfl_xor_f(v, o);
    return v;
}
HD void wjob(const Params& p, int j, const float*& src, int& K, int& N, bf16_t*& dst, int& gate_id) {
    gate_id = -1;
    switch (j) {
        case 0: src = p.in[I_LWIN]; K = 1024; N = 2048; dst = (bf16_t*)(p.ws + W_IN0); break;
        case 1: src = p.in[I_LWO]; K = 1024; N = 1024; dst = (bf16_t*)(p.ws + W_OUT0); break;
        case 2: src = p.in[I_W1]; K = 1024; N = 4096; dst = (bf16_t*)(p.ws + W_M1_0); break;
        case 3: src = p.in[I_W2]; K = 4096; N = 1024; dst = (bf16_t*)(p.ws + W_M2_0); break;
        case 4: src = p.in[I_HWIN]; K = 1024; N = 3072; dst = (bf16_t*)(p.ws + W_HYIN); break;
        case 5: src = p.in[I_HWO]; K = 1024; N = 1024; dst = (bf16_t*)(p.ws + W_HYOUT); break;
        case 6: src = p.in[I_W1] + (size_t)1024 * 4096; K = 1024; N = 4096; dst = (bf16_t*)(p.ws + W_M1_1); break;
        case 7: src = p.in[I_W2] + (size_t)1024 * 4096; K = 4096; N = 1024; dst = (bf16_t*)(p.ws + W_M2_1); break;
        default: { const int id = j - 8, n = id & 1, dir = (id >> 1) & 1, head = id >> 2; gate_id = id;
            src = (n ? p.in[I_LWI] : p.in[I_LWA]) + (size_t)(dir * 4 + head) * 65536; K = 256; N = 256; dst = (bf16_t*)(p.ws + W_GATE); } break;
    }
}
HD void phase_prep(const Params& p, float* lds, bool do_mods) {
    int tid = ltid(); asm volatile("" : "+v"(tid)); const int bid = blockIdx.x, nb = gridDim.x;
    {
        const int ntiles[9] = {512, 256, 1024, 1024, 768, 256, 1024, 1024, 256};
        const int grp = tid >> 7, t = tid & 127;
        float* tl = lds + grp * (64 * 65);
#pragma unroll 1
        for (int it = bid; it < 6144 / 4; it += nb) {
            const int tI = it * 4 + grp;
            int j = 0, rem = tI;
#pragma unroll
            for (int q = 0; q < 8; ++q) if (j == q && rem >= ntiles[q]) { rem -= ntiles[q]; j = q + 1; }
            if (j == 8) { j = 8 + (rem >> 4); rem &= 15; }
            const float* src; int K, N, gid; bf16_t* dst; wjob(p, j, src, K, N, dst, gid);
            const int ntn = N / 64, k0 = (rem / ntn) * 64, n0 = (rem % ntn) * 64;
            { const int r = t >> 4, c4 = t & 15;
              f32x4 v[8];
#pragma unroll
              for (int ps = 0; ps < 8; ++ps) v[ps] = *(const f32x4*)(src + (size_t)(k0 + r + 8 * ps) * N + n0 + c4 * 4);
#pragma unroll
              for (int ps = 0; ps < 8; ++ps) { const int k = r + 8 * ps; tl[k * 65 + c4 * 4 + 0] = v[ps][0]; tl[k * 65 + c4 * 4 + 1] = v[ps][1]; tl[k * 65 + c4 * 4 + 2] = v[ps][2]; tl[k * 65 + c4 * 4 + 3] = v[ps][3]; } }
            __syncthreads();
            { const int nn = t >> 1, kh = t & 1;
              int drow = n0 + nn;
              if (gid >= 0) { const int n = gid & 1, dir = (gid >> 1) & 1, head = gid >> 2, jc = n0 + nn, half = jc >> 7, ch = jc & 127;
                  const int rho = ((ch >> 6) << 7) | (((ch >> 4) & 3) << 5) | (n << 4) | (ch & 15); drow = (head * 4 + dir * 2 + half) * 256 + rho; }
#pragma unroll
              for (int q8 = 0; q8 < 4; ++q8) { float v[8];
#pragma unroll
                  for (int q = 0; q < 8; ++q) v[q] = tl[(kh * 32 + q8 * 8 + q) * 65 + nn];
                  u32x4 w; w.x = cvt_pk_bf16(v[0], v[1]); w.y = cvt_pk_bf16(v[2], v[3]); w.z = cvt_pk_bf16(v[4], v[5]); w.w = cvt_pk_bf16(v[6], v[7]);
                  *(u32x4*)(dst + (size_t)drow * K + k0 + kh * 32 + q8 * 8) = w; } }
            __syncthreads();
        }
    }
    if (do_mods) {
        float* modp = (float*)(p.ws + OFF_MODP);
        const int gw = bid * 8 + (tid >> 6), nw = nb * 8, lane = tid & 63;
#pragma unroll 1
        for (int it = gw; it < 1536; it += nw) {
            const int kc = it & 31, cgp = (it >> 5) % 24, layer = it / (32 * 24);
            const int col = cgp * 256 + lane * 4;
            const float* wbase = p.in[I_ADAW] + (size_t)layer * 1024 * 6144 + col;
            f32x4 a[5];
#pragma unroll
            for (int v = 0; v < 5; ++v) a[v] = (f32x4){0.f, 0.f, 0.f, 0.f};
            if (kc == 0) { const f32x4 bv = *(const f32x4*)(p.in[I_ADAB] + layer * 6144 + col);
#pragma unroll
                for (int v = 0; v < 5; ++v) a[v] = bv; }
#pragma unroll 8
            for (int kk = 0; kk < 32; ++kk) {
                const int k = kc * 32 + kk;
                const f32x4 wv = *(const f32x4*)(wbase + (size_t)k * 6144);
#pragma unroll
                for (int v = 0; v < 5; ++v) { const float c = (v < 4) ? p.in[I_C][v * 1024 + k] : p.in[I_CCTX][k]; const float s = c * fsigmoid(c); a[v] += wv * s; }
            }
#pragma unroll
            for (int v = 0; v < 5; ++v) *(f32x4*)(modp + ((size_t)kc * 10 + layer * 5 + v) * 6144 + col) = a[v];
        }
    }
    const int gt = bid * NT + tid, ngt = nb * NT;
    for (int i = gt; i < 2048; i += ngt) { const float l = p.in[I_LAM][i]; const float x = __expf(-l); ((float*)(p.ws + OFF_SP))[i] = x * (1.0f - x * (0.5f - x * (0.33333334f - 0.25f * x))); }
    { bf16_t* o = (bf16_t*)(p.ws + OFF_FW4T);
      for (int i = gt; i < 4096 * 64; i += ngt) { const int n = i & 4095, f = i >> 12; const float w = p.in[I_FW4][(size_t)f * 4096 + n];
          const bf16_t h = f2bf(w); const bf16_t l = f2bf(w - bf2f(h)); bf16_t* r = o + (size_t)n * 256; r[f] = h; r[64 + f] = h; r[128 + f] = l; r[192 + f] = 0; } }
    {
        float* pos = lds; float* hA = lds + 8 * 33; float* hB = hA + 8 * 64;
        float* w1 = hB + 8 * 64; float* w2 = w1 + 33 * 64; float* w3 = w2 + 64 * 64;
        __syncthreads();
        for (int i = tid; i < 33 * 64; i += NT) w1[i] = p.in[I_FW1][i];
        for (int i = tid; i < 64 * 64; i += NT) { w2[i] = p.in[I_FW2][i]; w3[i] = p.in[I_FW3][i]; }
        const int tl = tid >> 6, f = tid & 63;
        const float fr = p.in[I_FREQ][f];
        bf16_t* o = (bf16_t*)(p.ws + OFF_BH3);
#pragma unroll 1
        for (int it = bid; it < 1024; it += nb) {
            const int ti = it * 8 + tl;
            __syncthreads();
            if (f < 33) {
                float v;
                if (f == 0) v = (float)ti * (1.0f / 8191.0f);
                else { const int j = (f - 1) & 15; const float band = 1e-4f + (float)j * ((15.0f - 1e-4f) / 15.0f); const float w = (6.283185307179586f / 8192.0f) * (float)ti;
                    v = (f <= 16) ? __cosf(band * w) : -__sinf(band * w); }
                pos[tl * 33 + f] = v;
            }
            __syncthreads();
            float a = p.in[I_FB1][f];
#pragma unroll 3
            for (int e = 0; e < 33; ++e) a += pos[tl * 33 + e] * w1[e * 64 + f];
            hA[tl * 64 + f] = __sinf(fr * a);
            __syncthreads();
            a = p.in[I_FB2][f];
#pragma unroll 8
            for (int e = 0; e < 64; ++e) a += hA[tl * 64 + e] * w2[e * 64 + f];
            hB[tl * 64 + f] = __sinf(fr * a);
            __syncthreads();
            a = p.in[I_FB3][f];
#pragma unroll 8
            for (int e = 0; e < 64; ++e) a += hB[tl * 64 + e] * w3[e * 64 + f];
            const float h = __sinf(fr * a);
            const bf16_t hh = f2bf(h); const bf16_t hl = f2bf(h - bf2f(hh));
            bf16_t* r = o + (size_t)ti * 256; r[f] = hh; r[64 + f] = hl; r[128 + f] = hh; r[192 + f] = 0;
        }
        __syncthreads();
    }
}
HD void phase_norm(const float* xmain, const float* xctx, int nrows, const float* g, const float* modl, int shc, int scc, bf16_t* Umain, bf16_t* Uctx) {
    const int lane = ltid() & 63, gw = blockIdx.x * 8 + (ltid() >> 6), nw = gridDim.x * 8;
#pragma unroll 1
    for (int rp = gw; rp < nrows / 2; rp += nw) {
        const int row = rp * 2;
        const bool isc = row >= M;
        const float* src = isc ? xctx + (size_t)(row - M) * 1024 : xmain + (size_t)row * 1024;
        const float* mv = modl + (isc ? 4 : (row >> 13)) * 6144;
        bf16_t* dst = isc ? Uctx + (size_t)(row - M) * 1024 : Umain + (size_t)row * 1024;
        f32x4 v[2][4];
#pragma unroll
        for (int r = 0; r < 2; ++r) { v[r][0] = *(const f32x4*)(src + r * 1024 + lane * 8); v[r][1] = *(const f32x4*)(src + r * 1024 + lane * 8 + 4);
            v[r][2] = *(const f32x4*)(src + r * 1024 + 512 + lane * 8); v[r][3] = *(const f32x4*)(src + r * 1024 + 512 + lane * 8 + 4); }
        float rstd[2];
#pragma unroll
        for (int r = 0; r < 2; ++r) { float ss = 0.f;
#pragma unroll
            for (int q = 0; q < 4; ++q) ss += v[r][q][0] * v[r][q][0] + v[r][q][1] * v[r][q][1] + v[r][q][2] * v[r][q][2] + v[r][q][3] * v[r][q][3];
            ss = wave_sum(ss); rstd[r] = rsqrtf(ss * (1.0f / 1024.0f) + 1e-6f); }
#pragma unroll
        for (int hf = 0; hf < 2; ++hf) {
            const int c = hf * 512 + lane * 8;
            float gs[8], sh[8];
#pragma unroll
            for (int q = 0; q < 2; ++q) {
                const f32x4 gg = *(const f32x4*)(g + c + q * 4), s4 = *(const f32x4*)(mv + shc * 1024 + c + q * 4), sc = *(const f32x4*)(mv + scc * 1024 + c + q * 4);
#pragma unroll
                for (int j = 0; j < 4; ++j) { gs[q * 4 + j] = gg[j] * (1.0f + sc[j]); sh[q * 4 + j] = s4[j]; }
            }
#pragma unroll
            for (int r = 0; r < 2; ++r) {
                float o[8];
#pragma unroll
                for (int q = 0; q < 2; ++q)
#pragma unroll
                    for (int j = 0; j < 4; ++j) o[q * 4 + j] = v[r][hf * 2 + q][j] * rstd[r] * gs[q * 4 + j] + sh[q * 4 + j];
                u32x4 w; w.x = cvt_pk_bf16(o[0], o[1]); w.y = cvt_pk_bf16(o[2], o[3]); w.z = cvt_pk_bf16(o[4], o[5]); w.w = cvt_pk_bf16(o[6], o[7]);
                *(u32x4*)(dst + r * 1024 + c) = w;
            }
        }
    }
}
HD void phase_shw(const Params& p) {
    const float* mod0 = (const float*)(p.ws + OFF_MOD); const float* mod1 = mod0 + 5 * 6144;
    float* shw = (float*)(p.ws + OFF_SHWP);
    const int lane = ltid() & 63, gw = blockIdx.x * 8 + (ltid() >> 6), nw = gridDim.x * 8;
#pragma unroll 1
    for (int it = gw; it < 44 * 32; it += nw) {
        const int kc = it & 31, cg = it >> 5;
        const float* W; const float* sh; float* o; int N, cgl;
        if (cg < 16) { W = p.in[I_W1]; sh = mod0 + 3 * 1024; o = shw; N = 4096; cgl = cg; }
        else if (cg < 28) { W = p.in[I_HWIN]; sh = mod1; o = shw + 4 * 4096; N = 3072; cgl = cg - 16; }
        else { W = p.in[I_W1] + (size_t)1024 * 4096; sh = mod1 + 3 * 1024; o = shw + 4 * 4096 + 4 * 3072; N = 4096; cgl = cg - 28; }
        const int col = cgl * 256 + lane * 4;
        f32x4 a[4];
#pragma unroll
        for (int v = 0; v < 4; ++v) a[v] = (f32x4){0.f, 0.f, 0.f, 0.f};
#pragma unroll 8
        for (int kk = 0; kk < 32; ++kk) {
            const int k = kc * 32 + kk;
            const f32x4 wv = *(const f32x4*)(W + (size_t)k * N + col);
#pragma unroll
            for (int v = 0; v < 4; ++v) a[v] += wv * sh[v * 6144 + k];
        }
#pragma unroll
        for (int v = 0; v < 4; ++v) *(f32x4*)(o + (size_t)kc * 45056 + (size_t)v * N + col) = a[v];
    }
}
HD void phase_final_norm(const bf16_t* xs, float* x, const float* g) {
    const int lane = ltid() & 63, gw = blockIdx.x * 8 + (ltid() >> 6), nw = gridDim.x * 8;
    f32x4 gg[4];
#pragma unroll
    for (int q = 0; q < 4; ++q) gg[q] = *(const f32x4*)(g + (q >> 1) * 512 + lane * 8 + (q & 1) * 4);
#pragma unroll 1
    for (int r4 = gw; r4 < M / 4; r4 += nw) {
        const bf16_t* src = xs + (size_t)r4 * 4096; float* dst = x + (size_t)r4 * 4096;
        u32x4 h[4][2];
#pragma unroll
        for (int r = 0; r < 4; ++r) { h[r][0] = *(const u32x4*)(src + r * 1024 + lane * 8); h[r][1] = *(const u32x4*)(src + r * 1024 + 512 + lane * 8); }
#pragma unroll
        for (int r = 0; r < 4; ++r) {
            f32x4 v[4];
#pragma unroll
            for (int hf = 0; hf < 2; ++hf) { const u32x4 t = h[r][hf]; v[hf * 2] = (f32x4){bf_lo(t.x), bf_hi(t.x), bf_lo(t.y), bf_hi(t.y)}; v[hf * 2 + 1] = (f32x4){bf_lo(t.z), bf_hi(t.z), bf_lo(t.w), bf_hi(t.w)}; }
            float ss = 0.f;
#pragma unroll
            for (int q = 0; q < 4; ++q) ss += v[q][0] * v[q][0] + v[q][1] * v[q][1] + v[q][2] * v[q][2] + v[q][3] * v[q][3];
            ss = wave_sum(ss);
            const float rstd = rsqrtf(ss * (1.0f / 1024.0f) + 1e-6f);
#pragma unroll
            for (int q = 0; q < 4; ++q) *(f32x4*)(dst + r * 1024 + (q >> 1) * 512 + lane * 8 + (q & 1) * 4) = v[q] * rstd * gg[q];
        }
    }
}
HD void phase_lru_conv(const Params& p) {
    const bf16_t* ZR = (const bf16_t*)(p.out) + (size_t)M * 1024;
    const bf16_t* ZRc = (const bf16_t*)(p.ws + OFF_ZRC);
    bf16_t* XL = (bf16_t*)(p.ws + OFF_U); bf16_t* XLc = (bf16_t*)(p.ws + OFF_UC);
    const float* cw = p.in[I_LCW]; const float* cb = p.in[I_LCB];
    const int gt = blockIdx.x * NT + ltid(), ngt = gridDim.x * NT;
    for (int idx = gt; idx < ((M + MC) / 16) * 128; idx += ngt) {
        const int cgp = idx & 127, seg = idx >> 7, c = cgp * 8;
        int t0 = seg * 16; const bf16_t* src; bf16_t* dst; int pos, rl;
        if (t0 < M) { src = ZR; dst = XL; pos = t0 & 63; rl = 64; } else { t0 -= M; src = ZRc; dst = XLc; pos = t0 & 255; rl = 256; }
        float w[4][8], bb[8];
#pragma unroll
        for (int k = 0; k < 4; ++k) { const f32x4 a = *(const f32x4*)(cw + k * 1024 + c), b = *(const f32x4*)(cw + k * 1024 + c + 4);
#pragma unroll
            for (int j = 0; j < 4; ++j) { w[k][j] = a[j]; w[k][4 + j] = b[j]; } }
        { const f32x4 a = *(const f32x4*)(cb + c), b = *(const f32x4*)(cb + c + 4);
#pragma unroll
          for (int j = 0; j < 4; ++j) { bb[j] = a[j]; bb[4 + j] = b[j]; } }
        u32x4 win[4];
#pragma unroll
        for (int q = 0; q < 3; ++q) { const int dt = q - 2, pp = pos + dt; win[q + 1] = (pp >= 0 && pp < rl) ? *(const u32x4*)(src + (size_t)(t0 + dt) * 1024 + c) : (u32x4){0u, 0u, 0u, 0u}; }
#pragma unroll
        for (int i = 0; i < 16; ++i) {
            win[0] = win[1]; win[1] = win[2]; win[2] = win[3];
            { const int pp = pos + i + 1; win[3] = (pp < rl) ? *(const u32x4*)(src + (size_t)(t0 + i + 1) * 1024 + c) : (u32x4){0u, 0u, 0u, 0u}; }
            float o[8];
#pragma unroll
            for (int j = 0; j < 8; ++j) o[j] = bb[j];
#pragma unroll
            for (int k = 0; k < 4; ++k) {
                const u32x4 r = win[k];
                o[0] += w[k][0] * bf_lo(r.x); o[1] += w[k][1] * bf_hi(r.x); o[2] += w[k][2] * bf_lo(r.y); o[3] += w[k][3] * bf_hi(r.y);
                o[4] += w[k][4] * bf_lo(r.z); o[5] += w[k][5] * bf_hi(r.z); o[6] += w[k][6] * bf_lo(r.w); o[7] += w[k][7] * bf_hi(r.w);
            }
            u32x4 wv; wv.x = cvt_pk_bf16(o[0], o[1]); wv.y = cvt_pk_bf16(o[2], o[3]); wv.z = cvt_pk_bf16(o[4], o[5]); wv.w = cvt_pk_bf16(o[6], o[7]);
            *(u32x4*)(dst + (size_t)(t0 + i) * 1024 + c) = wv;
        }
    }
}
HD void phase_scan_sum(const Params& p) {
    const int gt = blockIdx.x * NT + ltid(), ngt = gridDim.x * NT;
    float* SA = (float*)(p.ws + OFF_SUMA); float* SH = (float*)(p.ws + OFF_SUMH);
    for (int idx = gt; idx < 128 * 2 * 528; idx += ngt) {
        const int c = (idx & 127) * 8, rest = idx >> 7, dir = rest & 1, chunk = rest >> 1;
        const bf16_t* la; const bf16_t* bx; int b, slot; size_t r0;
        if (chunk < 512) { b = chunk >> 7; const int cc = chunk & 127; slot = 4 + cc; r0 = (size_t)b * 8192 + cc * 64;
            la = (const bf16_t*)(p.ws + OFF_LA) + (size_t)dir * M * 1024; bx = (const bf16_t*)(p.ws + OFF_BX) + (size_t)dir * M * 1024; }
        else { const int q = chunk - 512; b = q >> 2; const int cc = q & 3; slot = cc; r0 = (size_t)b * 256 + cc * 64;
            la = (const bf16_t*)(p.ws + OFF_LAC) + (size_t)dir * MC * 1024; bx = (const bf16_t*)(p.ws + OFF_BXC) + (size_t)dir * MC * 1024; }
        float A[8], H[8];
#pragma unroll
        for (int j = 0; j < 8; ++j) { A[j] = 0.f; H[j] = 0.f; }
#pragma unroll 16
        for (int i = 0; i < 64; ++i) {
            const int t = dir ? 63 - i : i;
            const u32x4 l = *(const u32x4*)(la + (r0 + t) * 1024 + c), x = *(const u32x4*)(bx + (r0 + t) * 1024 + c);
            const float lv[8] = {bf_lo(l.x), bf_hi(l.x), bf_lo(l.y), bf_hi(l.y), bf_lo(l.z), bf_hi(l.z), bf_lo(l.w), bf_hi(l.w)};
            const float xv[8] = {bf_lo(x.x), bf_hi(x.x), bf_lo(x.y), bf_hi(x.y), bf_lo(x.z), bf_hi(x.z), bf_lo(x.w), bf_hi(x.w)};
#pragma unroll
            for (int j = 0; j < 8; ++j) { A[j] += lv[j]; H[j] = __expf(lv[j]) * H[j] + xv[j]; }
        }
        const size_t o = ((size_t)(dir * 4 + b) * 132 + slot) * 1024 + c;
        *(f32x4*)(SA + o) = (f32x4){A[0], A[1], A[2], A[3]}; *(f32x4*)(SA + o + 4) = (f32x4){A[4], A[5], A[6], A[7]};
        *(f32x4*)(SH + o) = (f32x4){H[0], H[1], H[2], H[3]}; *(f32x4*)(SH + o + 4) = (f32x4){H[4], H[5], H[6], H[7]};
    }
}
HD void phase_scan_final(const Params& p) {
    const int gt = blockIdx.x * NT + ltid(), ngt = gridDim.x * NT;
    const float* SA = (const float*)(p.ws + OFF_SUMA); const float* SH = (const float*)(p.ws + OFF_SUMH);
    const bf16_t* LA0 = (const bf16_t*)(p.ws + OFF_LA); const bf16_t* LA1 = LA0 + (size_t)M * 1024;
    const bf16_t* BX0 = (const bf16_t*)(p.ws + OFF_BX); const bf16_t* BX1 = BX0 + (size_t)M * 1024;
    const bf16_t* G = (const bf16_t*)(p.out);
    bf16_t* HG = (bf16_t*)(p.ws + OFF_HG);
    for (int idx = gt; idx < 4 * 128 * 256; idx += ngt) {
        const int c = (idx & 255) * 4, rest = idx >> 8, cc = rest & 127, b = rest >> 7;
        f32x4 hf = (f32x4){0.f, 0.f, 0.f, 0.f}, hb = hf;
#define SC_STEP(st, av, hv) { _Pragma("unroll") for (int j = 0; j < 4; ++j) st[j] = __expf(av[j]) * st[j] + hv[j]; }
        { const float* a = SA + ((size_t)(0 * 4 + b) * 132) * 1024 + c; const float* h = SH + ((size_t)(0 * 4 + b) * 132) * 1024 + c;
          const int n = 4 + cc; int s = 0;
#pragma unroll 1
          for (; s + 8 <= n; s += 8) { f32x4 av[8], hv[8];
#pragma unroll
              for (int q = 0; q < 8; ++q) { av[q] = *(const f32x4*)(a + (size_t)(s + q) * 1024); hv[q] = *(const f32x4*)(h + (size_t)(s + q) * 1024); }
#pragma unroll
              for (int q = 0; q < 8; ++q) SC_STEP(hf, av[q], hv[q]) }
#pragma unroll 1
          for (; s < n; ++s) { const f32x4 av = *(const f32x4*)(a + (size_t)s * 1024), hv = *(const f32x4*)(h + (size_t)s * 1024); SC_STEP(hf, av, hv) } }
        { const float* a = SA + ((size_t)(1 * 4 + b) * 132) * 1024 + c; const float* h = SH + ((size_t)(1 * 4 + b) * 132) * 1024 + c;
          { f32x4 av[4], hv[4];
#pragma unroll
            for (int q = 0; q < 4; ++q) { av[q] = *(const f32x4*)(a + (size_t)(3 - q) * 1024); hv[q] = *(const f32x4*)(h + (size_t)(3 - q) * 1024); }
#pragma unroll
            for (int q = 0; q < 4; ++q) SC_STEP(hb, av[q], hv[q]) }
          const int lo = 4 + cc; int s = 131;
#pragma unroll 1
          for (; s - 8 >= lo; s -= 8) { f32x4 av[8], hv[8];
#pragma unroll
              for (int q = 0; q < 8; ++q) { av[q] = *(const f32x4*)(a + (size_t)(s - q) * 1024); hv[q] = *(const f32x4*)(h + (size_t)(s - q) * 1024); }
#pragma unroll
              for (int q = 0; q < 8; ++q) SC_STEP(hb, av[q], hv[q]) }
#pragma unroll 1
          for (; s > lo; --s) { const f32x4 av = *(const f32x4*)(a + (size_t)s * 1024), hv = *(const f32x4*)(h + (size_t)s * 1024); SC_STEP(hb, av, hv) } }
#undef SC_STEP
        const size_t r0 = ((size_t)b * 8192 + cc * 64) * 1024 + c;
        unsigned hs[64][2];
#pragma unroll
        for (int i = 0; i < 64; ++i) {
            const u32x2 l = *(const u32x2*)(LA0 + r0 + (size_t)i * 1024), x = *(const u32x2*)(BX0 + r0 + (size_t)i * 1024);
            hf[0] = __expf(bf_lo(l.x)) * hf[0] + bf_lo(x.x); hf[1] = __expf(bf_hi(l.x)) * hf[1] + bf_hi(x.x);
            hf[2] = __expf(bf_lo(l.y)) * hf[2] + bf_lo(x.y); hf[3] = __expf(bf_hi(l.y)) * hf[3] + bf_hi(x.y);
            hs[i][0] = cvt_pk_bf16(hf[0], hf[1]); hs[i][1] = cvt_pk_bf16(hf[2], hf[3]);
        }
#pragma unroll
        for (int i = 63; i >= 0; --i) {
            const u32x2 l = *(const u32x2*)(LA1 + r0 + (size_t)i * 1024), x = *(const u32x2*)(BX1 + r0 + (size_t)i * 1024), gg = *(const u32x2*)(G + r0 + (size_t)i * 1024);
            hb[0] = __expf(bf_lo(l.x)) * hb[0] + bf_lo(x.x); hb[1] = __expf(bf_hi(l.x)) * hb[1] + bf_hi(x.x);
            hb[2] = __expf(bf_lo(l.y)) * hb[2] + bf_lo(x.y); hb[3] = __expf(bf_hi(l.y)) * hb[3] + bf_hi(x.y);
            u32x2 w;
            w.x = cvt_pk_bf16((bf_lo(hs[i][0]) + hb[0]) * bf_lo(gg.x), (bf_hi(hs[i][0]) + hb[1]) * bf_hi(gg.x));
            w.y = cvt_pk_bf16((bf_lo(hs[i][1]) + hb[2]) * bf_lo(gg.y), (bf_hi(hs[i][1]) + hb[3]) * bf_hi(gg.y));
            *(u32x2*)(HG + r0 + (size_t)i * 1024) = w;
        }
    }
}
HD void phase_hy_conv_T(const Params& p, unsigned* lds) {
    const bf16_t* Z3 = (const bf16_t*)(p.ws + OFF_Z3); bf16_t* T = (bf16_t*)(p.ws + OFF_T);
    const float* cw = p.in[I_HCW]; const float* cb = p.in[I_HCB];
    int tid = ltid(); asm volatile("" : "+v"(tid));
    u32x4 pre[4];
    { const int it0 = blockIdx.x; if (it0 < 256 * 24) { const int row = tid >> 4, c8 = tid & 15;
#pragma unroll
        for (int ps = 0; ps < 4; ++ps) pre[ps] = *(const u32x4*)(Z3 + (size_t)((it0 / 24) * 128 + row + 32 * ps) * 3072 + (it0 % 24) * 128 + c8 * 8); } }
    unsigned* const lds_base = lds; int par = 0;
    __syncthreads();
#pragma unroll 1
    for (int it = blockIdx.x; it < 256 * 24; it += gridDim.x) {
        const int ct = it % 24, tt = it / 24, c0 = ct * 128, t0 = tt * 128;
        lds = lds_base + par * 8192; par ^= 1;
        { const int row = tid >> 4, c8 = tid & 15;
#pragma unroll
          for (int ps = 0; ps < 4; ++ps) { const int t = row + 32 * ps; *(u32x4*)(lds + t * 64 + ((c8 * 4 + 4 * (t >> 3)) & 63)) = pre[ps]; }
          const int itn = it + gridDim.x;
          if (itn < 256 * 24) {
#pragma unroll
              for (int ps = 0; ps < 4; ++ps) pre[ps] = *(const u32x4*)(Z3 + (size_t)((itn / 24) * 128 + row + 32 * ps) * 3072 + (itn % 24) * 128 + c8 * 8); } }
        __syncthreads();
#pragma unroll
        for (int k = 0; k < 2; ++k) {
            const int item = tid + 512 * k, tg = item & 15, cp = item >> 4, gc = c0 + 2 * cp;
            float w0[3], w1[3];
#pragma unroll
            for (int q = 0; q < 3; ++q) { const f32x2 wv = *(const f32x2*)(cw + q * 3072 + gc); w0[q] = wv.x; w1[q] = wv.y; }
            const f32x2 bv = *(const f32x2*)(cb + gc);
            float z0[10], z1[10];
#pragma unroll
            for (int j = 0; j < 10; ++j) {
                const int t = 8 * tg + j - 1;
                const bool ok = (t >= 0) && (t < 128) && ((t >> 6) == (tg >> 3));
                const unsigned dw = ok ? lds[t * 64 + ((cp + 4 * (t >> 3)) & 63)] : 0u;
                z0[j] = bf_lo(dw); z1[j] = bf_hi(dw);
            }
            float o0[8], o1[8];
#pragma unroll
            for (int j = 0; j < 8; ++j) { o0[j] = bv.x + w0[0] * z0[j] + w0[1] * z0[j + 1] + w0[2] * z0[j + 2]; o1[j] = bv.y + w1[0] * z1[j] + w1[1] * z1[j + 1] + w1[2] * z1[j + 2]; }
            const int which = gc >> 10, d = gc & 1023, row = t0 + 8 * tg, b = row >> 13, t = row & 8191;
            bf16_t* dst = T + (((size_t)(which * 4 + b) * 1024 + d) * 8192 + t);
            u32x4 w; w.x = cvt_pk_bf16(o0[0], o0[1]); w.y = cvt_pk_bf16(o0[2], o0[3]); w.z = cvt_pk_bf16(o0[4], o0[5]); w.w = cvt_pk_bf16(o0[6], o0[7]);
            *(u32x4*)dst = w;
            w.x = cvt_pk_bf16(o1[0], o1[1]); w.y = cvt_pk_bf16(o1[2], o1[3]); w.z = cvt_pk_bf16(o1[4], o1[5]); w.w = cvt_pk_bf16(o1[6], o1[7]);
            *(u32x4*)(dst + 8192) = w;
        }
    }
    __syncthreads();
}
HD void phase_T_back(const Params& p, unsigned* lds) {
    const bf16_t* VT = (const bf16_t*)(p.ws + OFF_T); bf16_t* Y2 = (bf16_t*)(p.ws + OFF_Y2);
    int tid = ltid(); asm volatile("" : "+v"(tid));
    u32x4 pre[4];
    { const int it0 = blockIdx.x; if (it0 < 2048) { const int row = tid >> 4, t8 = tid & 15, dt = it0 & 7, tt = it0 >> 3, b = tt >> 6, t0 = (tt & 63) * 128, d0 = dt * 128;
#pragma unroll
        for (int ps = 0; ps < 4; ++ps) pre[ps] = *(const u32x4*)(VT + ((size_t)(b * 1024 + d0 + row + 32 * ps) * 8192 + t0 + t8 * 8)); } }
    unsigned* const lds_base = lds; int par = 0;
    __syncthreads();
#pragma unroll 1
    for (int it = blockIdx.x; it < 2048; it += gridDim.x) {
        const int dt = it & 7, tt = it >> 3, b = tt >> 6, t0 = (tt & 63) * 128, d0 = dt * 128;
        lds = lds_base + par * 8192; par ^= 1;
        { const int row = tid >> 4, t8 = tid & 15;
#pragma unroll
          for (int ps = 0; ps < 4; ++ps) { const int dl = row + 32 * ps; *(u32x4*)(lds + dl * 64 + ((t8 * 4 + 4 * (dl >> 3)) & 63)) = pre[ps]; }
          const int itn = it + gridDim.x;
          if (itn < 2048) { const int dtn = itn & 7, ttn = itn >> 3, bn = ttn >> 6, t0n = (ttn & 63) * 128, d0n = dtn * 128;
#pragma unroll
              for (int ps = 0; ps < 4; ++ps) pre[ps] = *(const u32x4*)(VT + ((size_t)(bn * 1024 + d0n + row + 32 * ps) * 8192 + t0n + t8 * 8)); } }
        __syncthreads();
#pragma unroll
        for (int k = 0; k < 2; ++k) {
            const int item = tid + 512 * k, dg = item & 15, tp = item >> 4;
            unsigned v[8];
#pragma unroll
            for (int j = 0; j < 8; ++j) v[j] = lds[(8 * dg + j) * 64 + ((tp + 4 * dg) & 63)];
            u32x4 lo, hi;
            lo.x = (v[0] & 0xffffu) | (v[1] << 16); lo.y = (v[2] & 0xffffu) | (v[3] << 16); lo.z = (v[4] & 0xffffu) | (v[5] << 16); lo.w = (v[6] & 0xffffu) | (v[7] << 16);
            hi.x = (v[0] >> 16) | (v[1] & 0xffff0000u); hi.y = (v[2] >> 16) | (v[3] & 0xffff0000u); hi.z = (v[4] >> 16) | (v[5] & 0xffff0000u); hi.w = (v[6] >> 16) | (v[7] & 0xffff0000u);
            bf16_t* dst = Y2 + ((size_t)(b * 8192 + t0 + 2 * tp) * 1024 + d0 + 8 * dg);
            *(u32x4*)dst = lo; *(u32x4*)(dst + 1024) = hi;
        }
    }
    __syncthreads();
}
HD float block_sum(float v, float* red) {
    v = wave_sum(v);
    __syncthreads();
    if ((ltid() & 63) == 0) red[ltid() >> 6] = v;
    __syncthreads();
    float s = 0.f;
#pragma unroll
    for (int i = 0; i < 8; ++i) s += red[i];
    return s;
}
HD void phase_fft(const Params& p, float* re, float* im, float* red, bool do_store) {
    int tid = ltid();
    const bf16_t* HR = (const bf16_t*)(p.ws + OFF_HRAW);
    bf16_t* T = (bf16_t*)(p.ws + OFF_T);
    float* spec = (float*)(p.ws + OFF_SPEC + (size_t)blockIdx.x * 262144);
#pragma unroll 1
    for (int ch = blockIdx.x; ch < 1024; ch += gridDim.x) {
        OPAQUE(tid);
        const float kdec = -(3.0701134573253944f + (float)ch * (12.280453829301579f / 1023.0f)) * (1.0f / 8191.0f), rdec = __expf(kdec);
        {
            const bf16_t* h00 = HR + (size_t)(0 * 1024 + ch) * 8192; const bf16_t* h01 = HR + (size_t)(1 * 1024 + ch) * 8192;
            const bf16_t* h10 = HR + (size_t)(2 * 1024 + ch) * 8192; const bf16_t* h11 = HR + (size_t)(3 * 1024 + ch) * 8192;
            float s0 = 0.f, s1 = 0.f;
            unsigned t00[8], t10[8], t01[8], t11[8];
#pragma unroll
            for (int j = 0; j < 8; ++j) { const int n = 2 * (tid + 512 * j); t00[j] = *(const unsigned*)(h00 + n); t10[j] = *(const unsigned*)(h10 + n); t01[j] = *(const unsigned*)(h01 + n); t11[j] = *(const unsigned*)(h11 + n); }
#pragma unroll
            for (int j = 0; j < 8; ++j) { const int n = 2 * (tid + 512 * j);
                const unsigned u00 = t00[j], u10 = t10[j], u01 = t01[j], u11 = t11[j];
                const float e0 = __expf(kdec * (float)n), e1 = e0 * rdec;
                s0 += (fabsf(bf_lo(u00)) + fabsf(bf_lo(u10))) * e0 + (fabsf(bf_hi(u00)) + fabsf(bf_hi(u10))) * e1;
                s1 += (fabsf(bf_lo(u01)) + fabsf(bf_lo(u11))) * e0 + (fabsf(bf_hi(u01)) + fabsf(bf_hi(u11))) * e1; }
            s0 = block_sum(s0, red);
            s1 = block_sum(s1, red);
            const float inv0 = 1.0f / s0, inv1 = 1.0f / s1;
#pragma unroll
            for (int j = 0; j < 8; ++j) { const int n = 2 * (tid + 512 * j);
                const unsigned u00 = t00[j], u10 = t10[j], u01 = t01[j], u11 = t11[j];
                const float e0 = __expf(kdec * (float)n), e1 = e0 * rdec;
                const float a0 = e0 * inv0, a1 = e1 * inv0, b0 = e0 * inv1, b1 = e1 * inv1;
                if (n == 0) { re[PIX(0)] = (bf_lo(u00) + bf_lo(u10)) * a0; im[PIX(0)] = (bf_lo(u01) + bf_lo(u11)) * b0; re[PIX(8192)] = 0.f; im[PIX(8192)] = 0.f; }
                else { re[PIX(n)] = bf_lo(u00) * a0; im[PIX(n)] = bf_lo(u01) * b0; re[PIX(16384 - n)] = bf_lo(u10) * a0; im[PIX(16384 - n)] = bf_lo(u11) * b0; }
                re[PIX(n + 1)] = bf_hi(u00) * a1; im[PIX(n + 1)] = bf_hi(u01) * b1; re[PIX(16383 - n)] = bf_hi(u10) * a1; im[PIX(16383 - n)] = bf_hi(u11) * b1; }
            __syncthreads();
            fft_pass16<1024, false, false>(re, im, ltid()); __syncthreads();
            fft_pass16<64, false, false>(re, im, ltid()); __syncthreads();
            fft_pass16<4, false, false>(re, im, ltid()); __syncthreads();
            fft_r4_fwd_inplace(re, im, ltid()); __syncthreads();
            fft_hermitian_unpack(re, im, spec, spec + 32768, 1.0f / 16384.0f, ltid());
            __syncthreads();
        }
        const float sk0 = p.in[I_SKIP][ch], sk1 = p.in[I_SKIP][1024 + ch];
#pragma unroll 1
        for (int pr = 0; pr < 2; ++pr) {
            OPAQUE(tid);
            bf16_t* vb0 = T + ((size_t)(0 * 4 + 2 * pr) * 1024 + ch) * 8192; bf16_t* vb1 = vb0 + (size_t)1024 * 8192;
            const bf16_t* x1b0 = vb0 + (size_t)4 * 1024 * 8192; const bf16_t* x1b1 = x1b0 + (size_t)1024 * 8192;
            const bf16_t* x2b0 = x1b0 + (size_t)4 * 1024 * 8192; const bf16_t* x2b1 = x2b0 + (size_t)1024 * 8192;
            unsigned vr0[8], vr1[8], ar0[8], ar1[8];
#pragma unroll
            for (int j = 0; j < 8; ++j) { const int n = 2 * (tid + 512 * j); vr0[j] = *(const unsigned*)(vb0 + n); vr1[j] = *(const unsigned*)(vb1 + n); }
#pragma unroll
            for (int j = 0; j < 8; ++j) { const int n = 2 * (tid + 512 * j); ar0[j] = *(const unsigned*)(x1b0 + n); ar1[j] = *(const unsigned*)(x1b1 + n); }
#pragma unroll
            for (int j = 0; j < 8; ++j) { const int n = 2 * (tid + 512 * j);
                *(v2*)(re + PIX(n)) = v2{bf_lo(vr0[j]), bf_hi(vr0[j])}; *(v2*)(im + PIX(n)) = v2{bf_lo(vr1[j]), bf_hi(vr1[j])}; }
            __syncthreads();
            fft_pass16<1024, false, true>(re, im, ltid()); __syncthreads();
            fft_pass16<64, false, false>(re, im, ltid()); __syncthreads();
            fft_pass16<4, false, false>(re, im, ltid()); __syncthreads();
            fft_r4<1>(re, im, spec, spec + 16384, 0.f, ltid()); __syncthreads();
            fft_pass16<4, true, false>(re, im, ltid()); __syncthreads();
            fft_pass16<64, true, false>(re, im, ltid()); __syncthreads();
            fft_pass16<1024, true, true>(re, im, ltid()); __syncthreads();
#pragma unroll
            for (int j = 0; j < 8; ++j) { const int n = 2 * (tid + 512 * j);
                const v2 y0 = *(const v2*)(re + PIX(n)), y1 = *(const v2*)(im + PIX(n));
                const float r00 = bf_lo(ar0[j]) * (y0.x + bf_lo(vr0[j]) * sk0), r01 = bf_hi(ar0[j]) * (y0.y + bf_hi(vr0[j]) * sk0);
                const float r10 = bf_lo(ar1[j]) * (y1.x + bf_lo(vr1[j]) * sk0), r11 = bf_hi(ar1[j]) * (y1.y + bf_hi(vr1[j]) * sk0);
                *(v2*)(re + PIX(n)) = v2{r00, r01}; *(v2*)(im + PIX(n)) = v2{r10, r11};
                vr0[j] = cvt_pk_bf16(r00, r01); vr1[j] = cvt_pk_bf16(r10, r11); }
#pragma unroll
            for (int j = 0; j < 8; ++j) { const int n = 2 * (tid + 512 * j); ar0[j] = *(const unsigned*)(x2b0 + n); ar1[j] = *(const unsigned*)(x2b1 + n); }
            __syncthreads();
            fft_pass16<1024, false, true>(re, im, ltid()); __syncthreads();
            fft_pass16<64, false, false>(re, im, ltid()); __syncthreads();
            fft_pass16<4, false, false>(re, im, ltid()); __syncthreads();
            fft_r4<1>(re, im, spec + 32768, spec + 32768 + 16384, 0.f, ltid()); __syncthreads();
            fft_pass16<4, true, false>(re, im, ltid()); __syncthreads();
            fft_pass16<64, true, false>(re, im, ltid()); __syncthreads();
            fft_pass16<1024, true, true>(re, im, ltid()); __syncthreads();
#pragma unroll
            for (int j = 0; j < 8; ++j) { const int n = 2 * (tid + 512 * j);
                const v2 y0 = *(const v2*)(re + PIX(n)), y1 = *(const v2*)(im + PIX(n));
                const float r00 = bf_lo(ar0[j]) * (y0.x + bf_lo(vr0[j]) * sk1), r01 = bf_hi(ar0[j]) * (y0.y + bf_hi(vr0[j]) * sk1);
                const float r10 = bf_lo(ar1[j]) * (y1.x + bf_lo(vr1[j]) * sk1), r11 = bf_hi(ar1[j]) * (y1.y + bf_hi(vr1[j]) * sk1);
                if (do_store) { *(unsigned*)(vb0 + n) = cvt_pk_bf16(r00, r01); *(unsigned*)(vb1 + n) = cvt_pk_bf16(r10, r11); } }
            __syncthreads();
        }
    }
}

HD void phase_sum_partials(const float* src, float* dst, int n) {
    for (int i = blockIdx.x * NT + ltid(); i < n / 4; i += gridDim.x * NT) {
        f32x4 s = *(const f32x4*)(src + (size_t)i * 4);
#pragma unroll 8
        for (int c = 1; c < 32; ++c) s += *(const f32x4*)(src + (size_t)c * n + (size_t)i * 4);
        *(f32x4*)(dst + (size_t)i * 4) = s;
    }
}
constexpr int N_PHASES = 22;
constexpr unsigned SKIPMASK = (1u << 8) | (1u << 11) | (1u << 17);
#ifndef PHMASK
#define PHMASK 0xffffffffu
#endif
#define PH_EN(n) (((PHMASK) >> (n)) & 1u)
__global__ void __launch_bounds__(512, 2) mega(Params p) {
    extern __shared__ __attribute__((aligned(16))) unsigned char shm[];
    cg::grid_group grid = cg::this_grid();
    LAS unsigned char* lds = (LAS unsigned char*)shm;
    unsigned char* ws = p.ws;
    const float* mod0 = (const float*)(ws + OFF_MOD); const float* mod1 = mod0 + 5 * 6144;
    unsigned long long* ss = (unsigned long long*)(ws + OFF_SSI); const float* shw = (const float*)(ws + OFF_SHW);
    volatile LAS unsigned* xst = (volatile LAS unsigned*)(lds + LDS_BYTES - 16);
    if (threadIdx.x == 0) { xst[0] = 0u; xst[1] = 0u; }
    __syncthreads();
    (void)xcd_barrier_post((unsigned*)(ws + OFF_BAR), xst);
    if (p.ph_lo < 0) grid.sync();
#ifndef REPMASK
#define REPMASK 0u
#endif
#if (REPMASK >> 14) & 1
#define FFT_STORE(pq) (((pq) & 1) != 0)
#else
#define FFT_STORE(pq) true
#endif
#ifdef EXTRA_SYNCS
#pragma unroll 1
    for (int i = 0; i < EXTRA_SYNCS; ++i) grid.sync();
#endif
    for (int pq = 2 * p.ph_lo; pq < 2 * p.ph_hi; ++pq) {
        const int kq = pq >> 1, ph = kq == 0 ? 0 : (kq == 1 ? 21 : kq - 1);
        if ((SKIPMASK >> ph) & 1u) continue;
        if ((pq & 1) && !(((REPMASK) >> ph) & 1u)) continue;
        if (pq > 2 * p.ph_lo) { XcdBarrier xb; xb.bar = (unsigned*)(p.ws + OFF_BAR); xb.x = xb_xcc_id(); xb.st = (volatile LAS unsigned*)((LAS unsigned char*)shm + LDS_BYTES - 16); xcd_barrier(xb); }
        switch (ph) {
        case 0: if (PH_EN(0)) phase_prep(p, (float*)shm, !(pq & 1)); break;
        case 1: if (PH_EN(1)) { phase_norm(p.in[I_X], p.in[I_CTX], M + MC, p.in[I_NORMG], mod0, 0, 1, (bf16_t*)(ws + OFF_U), (bf16_t*)(ws + OFF_UC)); if (!(pq & 1)) phase_shw(p); } break;
        case 2: if (PH_EN(2)) { pg8::Gemm g{(const char*)(ws + OFF_U), (const char*)(ws + OFF_UC), (const char*)(ws + W_IN0), 1024, 1024, 1024, 132, 8, 128, 0, 0};
            EpiIn0 E{(bf16_t*)p.out, (bf16_t*)p.out + (size_t)M * 1024, (bf16_t*)(ws + OFF_ZRC), p.in[I_LBIN]}; pg8::gemm_phase(lds, g, E); } break;
        case 3: if (PH_EN(3)) { if (!(pq & 1)) phase_sum_partials((const float*)(ws + OFF_SHWP), (float*)(ws + OFF_SHW), 45056); phase_lru_conv(p); } break;
        case 4: if (PH_EN(4)) { pg8::Gemm g{(const char*)(ws + OFF_U), (const char*)(ws + OFF_UC), (const char*)(ws + W_GATE), 1024, 256, 256, 132, 16, 128, 2, 512};
            EpiGates E{(const bf16_t*)(ws + OFF_U), (const bf16_t*)(ws + OFF_UC), (bf16_t*)(ws + OFF_LA), (bf16_t*)(ws + OFF_BX), (bf16_t*)(ws + OFF_LAC), (bf16_t*)(ws + OFF_BXC),
                       p.in[I_LBA], p.in[I_LBI], (const float*)(ws + OFF_SP)}; pg8::gemm_phase(lds, g, E); } break;
        case 5: if (PH_EN(5)) phase_scan_sum(p); break;
        case 6: if (PH_EN(6)) phase_scan_final(p); break;
        case 7: if (PH_EN(7)) { pg8::Gemm g{(const char*)(ws + OFF_HG), nullptr, (const char*)(ws + W_OUT0), 1024, 1024, 1024, 128, 4, 1 << 30, 0, 0};
            EpiRes<2, false, true> E{p.in[I_X], p.out, mod0 + 2 * 1024, p.in[I_LBO], (bf16_t*)(ws + OFF_U), p.in[I_NORMG] + 1024, mod0 + 4 * 1024, ss}; pg8::gemm_phase(lds, g, E); } break;
        case 8: if (PH_EN(8)) phase_norm(p.out, nullptr, M, p.in[I_NORMG] + 1024, mod0, 3, 4, (bf16_t*)(ws + OFF_U), nullptr); break;
        case 9: if (PH_EN(9)) { pg8::Gemm g{(const char*)(ws + OFF_U), nullptr, (const char*)(ws + W_M1_0), 1024, 1024, 1024, 128, 16, 1 << 30, 0, 0};
            EpiBf16 E{(bf16_t*)(ws + OFF_H), 4096, nullptr, 1, ss, shw}; pg8::gemm_phase(lds, g, E); } break;
        case 10: if (PH_EN(10)) { pg8::Gemm g{(const char*)(ws + OFF_H), nullptr, (const char*)(ws + W_M2_0), 4096, 4096, 4096, 128, 4, 1 << 30, 0, 0};
            EpiRes<5, true, true> E{p.out, p.out, mod0 + 5 * 1024, nullptr, (bf16_t*)(ws + OFF_U), p.in[I_NORMG] + 2048, mod1 + 1 * 1024, ss + M}; pg8::gemm_phase(lds, g, E); } break;
        case 11: if (PH_EN(11)) phase_norm(p.out, nullptr, M, p.in[I_NORMG] + 2048, mod1, 0, 1, (bf16_t*)(ws + OFF_U), nullptr); break;
        case 12: if (PH_EN(12)) { pg8::Gemm g{(const char*)(ws + OFF_U), nullptr, (const char*)(ws + W_HYIN), 1024, 1024, 1024, 128, 12, 1 << 30, 0, 0};
            EpiBf16 E{(bf16_t*)(ws + OFF_Z3), 3072, p.in[I_HBIN], 0, ss + M, shw + 4 * 4096}; pg8::gemm_phase(lds, g, E); } break;
        case 13: if (PH_EN(13)) { pg8::Gemm g{(const char*)(ws + OFF_FW4T), nullptr, (const char*)(ws + OFF_BH3), 256, 256, 256, 16, 32, 1 << 30, 0, 0};
            EpiBf16 E{(bf16_t*)(ws + OFF_HRAW), 8192, nullptr, 0, nullptr, nullptr}; pg8::gemm_phase(lds, g, E);

#ifndef NO_CONVT
            phase_hy_conv_T(p, (unsigned*)shm);
#endif
            } break;
        case 14: if (PH_EN(14)) phase_fft(p, (float*)shm, (float*)shm + FFT_PLANE, (float*)shm + 2 * FFT_PLANE, FFT_STORE(pq)); break;
        case 15: if (PH_EN(15)) phase_T_back(p, (unsigned*)shm); break;
        case 16: if (PH_EN(16)) { pg8::Gemm g{(const char*)(ws + OFF_Y2), nullptr, (const char*)(ws + W_HYOUT), 1024, 1024, 1024, 128, 4, 1 << 30, 0, 0};
            EpiRes<5, true, true> E{p.out, p.out, mod1 + 2 * 1024, p.in[I_HBO], (bf16_t*)(ws + OFF_U), p.in[I_NORMG] + 3072, mod1 + 4 * 1024, ss + 2 * M}; pg8::gemm_phase(lds, g, E); } break;
        case 17: if (PH_EN(17)) phase_norm(p.out, nullptr, M, p.in[I_NORMG] + 3072, mod1, 3, 4, (bf16_t*)(ws + OFF_U), nullptr); break;
        case 18: if (PH_EN(18)) { pg8::Gemm g{(const char*)(ws + OFF_U), nullptr, (const char*)(ws + W_M1_1), 1024, 1024, 1024, 128, 16, 1 << 30, 0, 0};
            EpiBf16 E{(bf16_t*)(ws + OFF_H), 4096, nullptr, 1, ss + 2 * M, shw + 4 * 4096 + 4 * 3072}; pg8::gemm_phase(lds, g, E); } break;
        case 19: if (PH_EN(19)) { pg8::Gemm g{(const char*)(ws + OFF_H), nullptr, (const char*)(ws + W_M2_1), 4096, 4096, 4096, 128, 4, 1 << 30, 0, 0};
            EpiRes<6, true, true> E{p.out, ws + OFF_XF, mod1 + 5 * 1024, nullptr, nullptr, nullptr, nullptr, nullptr}; pg8::gemm_phase(lds, g, E); } break;
        case 20: if (PH_EN(20)) phase_final_norm((const bf16_t*)(ws + OFF_XF), p.out, p.in[I_FG]); break;
        case 21: phase_sum_partials((const float*)(ws + OFF_MODP), (float*)(ws + OFF_MOD), 61440); break;
        }
    }
}

extern "C" void kernel_launch(void* const* d_in, const int* in_sizes, int n_in, void* d_out, int out_size, void* d_ws, size_t ws_size, hipStream_t stream) {
    static int grid = 0;
    if (grid == 0) {
        if (n_in != 36 || out_size != M * D || ws_size < WS_NEED) { fprintf(stderr, "kernel_launch: unexpected shapes n_in %d out %d ws %zu\n", n_in, out_size, ws_size); grid = -1; return; }
        int dev = 0, cus = 0, per_cu = 0;
        hipGetDevice(&dev); hipDeviceGetAttribute(&cus, hipDeviceAttributeMultiprocessorCount, dev);
        if (hipFuncSetAttribute((const void*)mega, hipFuncAttributeMaxDynamicSharedMemorySize, LDS_BYTES) != hipSuccess) { fprintf(stderr, "kernel_launch: hipFuncSetAttribute failed\n"); grid = -1; return; }
        if (hipOccupancyMaxActiveBlocksPerMultiprocessor(&per_cu, (const void*)mega, NT, LDS_BYTES) != hipSuccess || per_cu < 1) { fprintf(stderr, "kernel_launch: occupancy query gave %d\n", per_cu); per_cu = 1; }
        (void)hipGetLastError();
        grid = cus * 1;
    }
    if (grid < 0) return;
    hipMemsetAsync((char*)d_ws + OFF_BAR, 0, 16 * 1024, stream);
    hipMemsetAsync((char*)d_ws + OFF_SSI, 0, (size_t)3 * 32768 * 8, stream);
    Params p{};
    for (int i = 0; i < 36; ++i) p.in[i] = (const float*)d_in[i];
    p.out = (float*)d_out; p.ws = (unsigned char*)d_ws;
#ifndef MK_LAUNCHES_PER_PHASE
    p.ph_lo = 0; p.ph_hi = N_PHASES;
    void* args[] = {&p};
    hipError_t e = hipLaunchCooperativeKernel((const void*)mega, dim3(grid), dim3(NT), args, LDS_BYTES, stream);
    if (e != hipSuccess) fprintf(stderr, "cooperative launch failed: %s (grid %d)\n", hipGetErrorString(e), grid);
#else
    for (int ph = 0; ph < N_PHASES; ++ph) {
        p.ph_lo = ph; p.ph_hi = ph + 1;
        void* args[] = {&p};
        hipError_t e = hipLaunchCooperativeKernel((const void*)mega, dim3(grid), dim3(NT), args, LDS_BYTES, stream);
        if (e != hipSuccess) fprintf(stderr, "launch %d failed: %s (grid %d)\n", ph, hipGetErrorString(e), grid);
    }
#endif
}
```
